# Optimizing an MI355X kernel written in HIP

```python
import math
import jax, jax.numpy as jnp
from jax import lax
import numpy as np

D_MODEL = 1024
BATCH = 16
SEQ = 256
DEPTH = 2
DEC_BATCH = 8
DEC_SEQ = 4096
PAST_LEN = 512

GRID_W = 64
DIFF_HEADS = 4
DIFF_DH = 64
RET_HEADS = 4
RET_DK = 64
RET_DV = 128
RET_CHUNK = 128
MLA_HEADS = 4
MLA_Q_LORA = 384
MLA_KV_LORA = 256
MLA_NOPE = 128
MLA_ROPE = 64
MLA_V = 128
N_BRANCH = 3
BRANCH_W = 512
D_FF = 4 * D_MODEL
Q_BLOCK = 128
ROT_DIM = 64
ROPE_BASE = 10000.0
EPS = 1e-6
SPLIT_SIZES = (
    DIFF_HEADS * 2 * DIFF_DH,
    DIFF_HEADS * 2 * DIFF_DH,
    DIFF_HEADS * 2 * DIFF_DH,
    RET_HEADS * RET_DK,
    RET_HEADS * RET_DK,
    RET_HEADS * RET_DV,
    RET_HEADS * RET_DV,
    MLA_Q_LORA,
    MLA_KV_LORA,
    MLA_ROPE,
    N_BRANCH * D_MODEL,
)
D_IN = sum(SPLIT_SIZES)

kernel_name = "hybrid_diffretmla_diffusion_step"

F32 = jnp.float32


def rmsnorm(x, g=None):
    x32 = x.astype(F32)
    y = x32 * lax.rsqrt(jnp.mean(jnp.square(x32), axis=-1, keepdims=True) + EPS)
    if g is not None:
        y = y * g.astype(F32)
    return y.astype(x.dtype)


def axial_rope_tables(n):
    n_rows = n // GRID_W
    row = jnp.repeat(jnp.arange(n_rows, dtype=F32), GRID_W)
    col = jnp.tile(jnp.arange(GRID_W, dtype=F32), n_rows)
    axis_dim = ROT_DIM // 2
    inv = ROPE_BASE ** (-jnp.arange(0, axis_dim, 2, dtype=F32) / axis_dim)
    ang_r = row[:, None] * inv[None, :]
    ang_c = col[:, None] * inv[None, :]
    return (jnp.cos(ang_r), jnp.sin(ang_r), jnp.cos(ang_c), jnp.sin(ang_c))


def _rotate(x, cos, sin):
    x1, x2 = jnp.split(x, 2, axis=-1)
    cos = cos[:, None, :].astype(x.dtype)
    sin = sin[:, None, :].astype(x.dtype)
    return jnp.concatenate([x1 * cos - x2 * sin, x2 * cos + x1 * sin], axis=-1)


def apply_axial_rope(x, tabs):
    cr, sr, cc, sc = tabs
    xr, xc = jnp.split(x, 2, axis=-1)
    return jnp.concatenate([_rotate(xr, cr, sr), _rotate(xc, cc, sc)], axis=-1)


def over_query_blocks(fn, q):
    B, N = q.shape[:2]
    nb = N // Q_BLOCK
    qb = jnp.moveaxis(q.reshape((B, nb, Q_BLOCK) + q.shape[2:]), 1, 0)
    ob = lax.map(fn, qb)
    return jnp.moveaxis(ob, 0, 1).reshape((B, N) + ob.shape[3:])


def diff_attention(q, k, v, lam):
    scale = DIFF_DH ** -0.5

    def blk(qb):
        s = jnp.einsum('bqgd,bkgd->bgqk', qb, k).astype(F32) * scale
        p = jax.nn.softmax(s, axis=-1)
        p = p.reshape(p.shape[0], DIFF_HEADS, 2, p.shape[2], p.shape[3])
        a = (p[:, :, 0] - lam * p[:, :, 1]).astype(v.dtype)
        return jnp.einsum('bhqk,bkhe->bqhe', a, v)

    return over_query_blocks(blk, q)


def softmax_attention(q, k, v, scale):
    def blk(qb):
        s = jnp.einsum('bqhd,bkhd->bhqk', qb, k).astype(F32) * scale
        p = jax.nn.softmax(s, axis=-1).astype(v.dtype)
        return jnp.einsum('bhqk,bkhe->bqhe', p, v)

    return over_query_blocks(blk, q)


def retention_scan(q, k, v, log_gamma, r0, strict):
    out_dtype = v.dtype
    B, N, H, _ = q.shape
    dv = v.shape[-1]
    C = RET_CHUNK
    nc = N // C

    def chunks(t):
        return jnp.moveaxis(t.astype(F32).reshape(B, nc, C, H, t.shape[-1]), 1, 0)

    idx = jnp.arange(C, dtype=F32)
    rel = idx[:, None] - idx[None, :]
    mask = (rel > 0) if strict else (rel >= 0)
    decay_in = jnp.where(mask[None], jnp.exp(jnp.where(mask, rel, 0.0)[None] * log_gamma[:, None, None]), 0.0)
    q_dec = jnp.exp((idx + 1.0)[:, None] * log_gamma[None, :])
    k_dec = jnp.exp((C - 1.0 - idx)[:, None] * log_gamma[None, :])
    chunk_dec = jnp.exp(C * log_gamma)[None, :, None, None]

    def step(R, xs):
        qc, kc, vc = xs
        s = jnp.einsum('bihd,bjhd->bhij', qc, kc) * decay_in[None]
        o = (jnp.einsum('bhij,bjhe->bihe', s, vc)
             + jnp.einsum('bihd,bhde->bihe', qc * q_dec[None, :, :, None], R))
        R = chunk_dec * R + jnp.einsum('bjhd,bjhe->bhde', kc * k_dec[None, :, :, None], vc)
        return R, o

    R, o = lax.scan(step, r0.astype(F32), (chunks(q), chunks(k), chunks(v)))
    o = jnp.moveaxis(o, 0, 1).reshape(B, N, H, dv).astype(out_dtype)
    return o, R


def mla_keys(ckv, kr, w_kvb, kn):
    B, K = ckv.shape[:2]
    kv = (ckv @ w_kvb).reshape(B, K, MLA_HEADS, MLA_NOPE + MLA_V)
    k_nope, v = jnp.split(kv, [MLA_NOPE], axis=-1)
    k = jnp.concatenate([k_nope, jnp.broadcast_to(kr[:, :, None, :], (B, K, MLA_HEADS, MLA_ROPE))], axis=-1)
    return rmsnorm(k, kn), v


def token_mixers(h, lw, lam_init, rope, ctx):
    B, N, _ = h.shape
    latent = ctx is not None
    offs = np.cumsum(SPLIT_SIZES)[:-1].tolist()
    z = h @ lw['w_in']
    d_q, d_k, d_v, r_q, r_k, r_v, r_g, m_qa, m_kva, m_kr, g = jnp.split(z, offs, axis=-1)

    dq = rmsnorm(d_q.reshape(B, N, 2 * DIFF_HEADS, DIFF_DH), lw['diff_qn'])
    dk = rmsnorm(d_k.reshape(B, N, 2 * DIFF_HEADS, DIFF_DH), lw['diff_kn'])
    dv = d_v.reshape(B, N, DIFF_HEADS, 2 * DIFF_DH)
    if latent:
        dq = apply_axial_rope(dq, rope)
        dk_all = jnp.concatenate([apply_axial_rope(dk, rope), ctx[0]], axis=1)
        dv_all = jnp.concatenate([dv, ctx[1]], axis=1)
    else:
        dk_all, dv_all = dk, dv
    lmb = lw['diff_lambda'].astype(F32)
    lam = jnp.exp(jnp.sum(lmb[0] * lmb[1])) - jnp.exp(jnp.sum(lmb[2] * lmb[3])) + lam_init
    oa = diff_attention(dq, dk_all, dv_all, lam)
    oa = (rmsnorm(oa, lw['diff_subln']) * (1.0 - lam_init)).reshape(B, N, BRANCH_W)

    rq = r_q.reshape(B, N, RET_HEADS, RET_DK)
    rk = r_k.reshape(B, N, RET_HEADS, RET_DK) * (RET_DK ** -0.5)
    rv = r_v.reshape(B, N, RET_HEADS, RET_DV)
    if latent:
        rq = apply_axial_rope(rq, rope)
        rk = apply_axial_rope(rk, rope)
        r0f, r0b = ctx[4][:, 0], ctx[4][:, 1]
    else:
        r0f = jnp.zeros((B, RET_HEADS, RET_DK, RET_DV), F32)
        r0b = r0f
    lg = jax.nn.log_sigmoid(lw['ret_decay'].astype(F32))
    of, Rf = retention_scan(rq, rk, rv, lg[0], r0f, strict=False)
    ob, Rb = retention_scan(jnp.flip(rq, 1), jnp.flip(rk, 1), jnp.flip(rv, 1), lg[1], r0b, strict=True)
    ob = jnp.flip(ob, 1)
    orr = rmsnorm(of + ob, lw['ret_gn']) * jax.nn.silu(r_g.reshape(B, N, RET_HEADS, RET_DV))
    orr = orr.reshape(B, N, BRANCH_W)

    mq = (rmsnorm(m_qa, lw['mla_qa_norm']) @ lw['w_mla_qb']).reshape(B, N, MLA_HEADS, MLA_NOPE + MLA_ROPE)
    mq = rmsnorm(mq, lw['mla_qn'])
    ckv = rmsnorm(m_kva, lw['mla_kva_norm'])
    mk, mv = mla_keys(ckv, m_kr, lw['w_mla_kvb'], lw['mla_kn'])
    if latent:
        mq = jnp.concatenate([mq[..., :MLA_NOPE], apply_axial_rope(mq[..., MLA_NOPE:], rope)], axis=-1)
        mk = jnp.concatenate([mk[..., :MLA_NOPE], apply_axial_rope(mk[..., MLA_NOPE:], rope)], axis=-1)
        ck, cv = mla_keys(ctx[2], ctx[3], lw['w_mla_kvb'], lw['mla_kn'])
        mk = jnp.concatenate([mk, ck], axis=1)
        mv = jnp.concatenate([mv, cv], axis=1)
    om = softmax_attention(mq, mk, mv, (MLA_NOPE + MLA_ROPE) ** -0.5).reshape(B, N, BRANCH_W)

    gates = jnp.split(g, N_BRANCH, axis=-1)
    merged = 0.0
    for i, o in enumerate((oa, orr, om)):
        merged = merged + jax.nn.sigmoid(gates[i]) * (o @ lw['w_branch'][i])
    out = merged @ lw['w_out']

    if latent:
        return out, None
    return out, (dk, dv, ckv, m_kr, jnp.stack([Rf, Rb], axis=1))


def block(x, cvec, lw, lam_init, rope, ctx):
    mod = (jax.nn.silu(cvec) @ lw['w_mod'] + lw['b_mod'])[:, None, :]
    sh1, sc1, g1, sh2, sc2, g2 = jnp.split(mod, 6, axis=-1)
    h = rmsnorm(x, lw['norm1']) * (1.0 + sc1) + sh1
    mix, ctx_out = token_mixers(h, lw, lam_init, rope, ctx)
    x = x + g1 * mix
    h = rmsnorm(x, lw['norm2']) * (1.0 + sc2) + sh2
    u = jnp.square(jax.nn.relu(h @ lw['w_up']))
    x = x + g2 * (u @ lw['w_down'])
    return x, ctx_out


def setup_inputs(seed: int = 0) -> dict:
    key = jax.random.key(seed)
    ks = iter(jax.random.split(key, 40))

    def nrm(shape, scale=1.0):
        return jax.random.normal(next(ks), shape, F32) * scale

    def gain(shape):
        return 1.0 + nrm(shape, 0.01)

    a = 5.0 + jnp.arange(RET_HEADS, dtype=F32)
    decay_logit = jnp.log(2.0 ** a - 1.0)
    return {
        "x_prompt": nrm((BATCH, SEQ, D_MODEL)),
        "x_sample": nrm((DEC_BATCH, DEC_SEQ, D_MODEL)),
        "cache_diff_k": nrm((DEC_BATCH, DEPTH, PAST_LEN, 2 * DIFF_HEADS, DIFF_DH)),
        "cache_diff_v": nrm((DEC_BATCH, DEPTH, PAST_LEN, DIFF_HEADS, 2 * DIFF_DH)),
        "cache_mla_ckv": nrm((DEC_BATCH, DEPTH, PAST_LEN, MLA_KV_LORA)),
        "cache_mla_krope": nrm((DEC_BATCH, DEPTH, PAST_LEN, MLA_ROPE)),
        "state_ret": nrm((DEC_BATCH, DEPTH, 2, RET_HEADS, RET_DK, RET_DV), 0.5),
        "c": nrm((DEC_BATCH, D_MODEL)),
        "c_ctx": nrm((D_MODEL,)),
        "w_mod": nrm((DEPTH, D_MODEL, 6 * D_MODEL), 0.5 * D_MODEL ** -0.5),
        "b_mod": nrm((DEPTH, 6 * D_MODEL), 0.01),
        "norm1": gain((DEPTH, D_MODEL)),
        "norm2": gain((DEPTH, D_MODEL)),
        "w_in": nrm((DEPTH, D_MODEL, D_IN), D_MODEL ** -0.5),
        "diff_qn": gain((DEPTH, DIFF_DH)),
        "diff_kn": gain((DEPTH, DIFF_DH)),
        "diff_lambda": nrm((DEPTH, 4, DIFF_DH), 0.1),
        "diff_subln": gain((DEPTH, 2 * DIFF_DH)),
        "ret_decay": decay_logit[None, None, :] + nrm((DEPTH, 2, RET_HEADS), 0.1),
        "ret_gn": gain((DEPTH, RET_DV)),
        "mla_qa_norm": gain((DEPTH, MLA_Q_LORA)),
        "w_mla_qb": nrm((DEPTH, MLA_Q_LORA, MLA_HEADS * (MLA_NOPE + MLA_ROPE)), MLA_Q_LORA ** -0.5),
        "mla_kva_norm": gain((DEPTH, MLA_KV_LORA)),
        "w_mla_kvb": nrm((DEPTH, MLA_KV_LORA, MLA_HEADS * (MLA_NOPE + MLA_V)), MLA_KV_LORA ** -0.5),
        "mla_qn": gain((DEPTH, MLA_NOPE + MLA_ROPE)),
        "mla_kn": gain((DEPTH, MLA_NOPE + MLA_ROPE)),
        "w_branch": nrm((DEPTH, N_BRANCH, BRANCH_W, D_MODEL), BRANCH_W ** -0.5),
        "w_out": nrm((DEPTH, D_MODEL, D_MODEL), D_MODEL ** -0.5),
        "w_up": nrm((DEPTH, D_MODEL, D_FF), D_MODEL ** -0.5),
        "w_down": nrm((DEPTH, D_FF, D_MODEL), D_FF ** -0.5),
    }


def reference(x_prompt, x_sample, cache_diff_k, cache_diff_v, cache_mla_ckv, cache_mla_krope, state_ret,
              c, c_ctx, w_mod, b_mod, norm1, norm2, w_in, diff_qn, diff_kn, diff_lambda, diff_subln,
              ret_decay, ret_gn, mla_qa_norm, w_mla_qb, mla_kva_norm, w_mla_kvb, mla_qn, mla_kn,
              w_branch, w_out, w_up, w_down):
    def layer_weights(l):
        return {
            'w_mod': w_mod[l], 'b_mod': b_mod[l], 'norm1': norm1[l], 'norm2': norm2[l],
            'w_in': w_in[l], 'diff_qn': diff_qn[l], 'diff_kn': diff_kn[l],
            'diff_lambda': diff_lambda[l], 'diff_subln': diff_subln[l],
            'ret_decay': ret_decay[l], 'ret_gn': ret_gn[l],
            'mla_qa_norm': mla_qa_norm[l], 'w_mla_qb': w_mla_qb[l], 'mla_kva_norm': mla_kva_norm[l],
            'w_mla_kvb': w_mla_kvb[l], 'mla_qn': mla_qn[l], 'mla_kn': mla_kn[l],
            'w_branch': w_branch[l], 'w_out': w_out[l], 'w_up': w_up[l], 'w_down': w_down[l],
        }

    def lambda_init(l):
        return 0.8 - 0.6 * math.exp(-0.3 * l)

    xp = x_prompt
    ks_, vs_, ckvs_, krs_, rs_ = [], [], [], [], []
    for l in range(DEPTH):
        xp, ctx_out = block(xp, c_ctx[None, :], layer_weights(l), lambda_init(l), None, None)
        ks_.append(ctx_out[0]); vs_.append(ctx_out[1]); ckvs_.append(ctx_out[2])
        krs_.append(ctx_out[3]); rs_.append(ctx_out[4])
    y_prompt = xp
    new_diff_k = jnp.stack(ks_, axis=1)
    new_diff_v = jnp.stack(vs_, axis=1)
    new_mla_ckv = jnp.stack(ckvs_, axis=1)
    new_mla_krope = jnp.stack(krs_, axis=1)
    new_state_ret = jnp.stack(rs_, axis=1)

    rope = axial_rope_tables(x_sample.shape[1])
    xs = x_sample
    for l in range(DEPTH):
        ctx = (cache_diff_k[:, l], cache_diff_v[:, l], cache_mla_ckv[:, l], cache_mla_krope[:, l], state_ret[:, l])
        xs, _ = block(xs, c, layer_weights(l), lambda_init(l), rope, ctx)
    y_sample = xs

    return (y_prompt, y_sample, new_diff_k, new_diff_v, new_mla_ckv, new_mla_krope, new_state_ret)
```

```cpp
#include <hip/hip_runtime.h>
#include <hip/hip_cooperative_groups.h>
#include <cstdio>
namespace cg = cooperative_groups;

typedef unsigned short bf16_t;
typedef __bf16 bf16x2_t __attribute__((ext_vector_type(2)));
typedef float f32x2_t __attribute__((ext_vector_type(2)));
using bf16x8 = __attribute__((ext_vector_type(8))) short;
using f32x16 = __attribute__((ext_vector_type(16))) float;
using u32x4 = __attribute__((ext_vector_type(4))) unsigned;
#define DI __device__ __forceinline__
#define MFMA(a, b, c) __builtin_amdgcn_mfma_f32_32x32x16_bf16((a), (b), (c), 0, 0, 0)

DI unsigned pk2(float a, float b) { f32x2_t v = {a, b}; return __builtin_bit_cast(unsigned, __builtin_convertvector(v, bf16x2_t)); }
DI bf16_t f2bf(float a) { return (bf16_t)(pk2(a, 0.f) & 0xffffu); }
DI float bflo(unsigned u) { return __uint_as_float(u << 16); }
DI float bfhi(unsigned u) { return __uint_as_float(u & 0xffff0000u); }

#ifndef PROBE_MLA2
#define PROBE_MLA2 0
#endif
#ifndef PROBE_P5
#define PROBE_P5 0
#endif
#ifndef PROBE_G1
#define PROBE_G1 0
#endif
#ifndef PROBE_UP2
#define PROBE_UP2 0
#endif
#ifndef PROBE_SYNC2
#define PROBE_SYNC2 0
#endif
constexpr int NZ = 3776;
constexpr int TG = 20480;
constexpr int TLG = 16384;
constexpr int KVR = 22528;
constexpr float EPS = 1e-6f;
constexpr float LOG2E = 1.4426950408889634f;

constexpr int LDH = 1088, LDU = 4160, LDM = 1088, LDO = 576;
constexpr int LW1 = 1088, LWQB = 448, LWKVB = 320, LWBR = 576, LWDN = 4160;
constexpr size_t W_IN = 6848ull * LW1, W_QB = 768ull * LWQB, W_KVB = 1024ull * LWKVB, W_BR = 3ull * 1024 * LWBR,
                 W_OUT = 1024ull * LW1, W_UP = 4096ull * LW1, W_DN = 1024ull * LWDN;
constexpr size_t WO_IN = 0, WO_QB = WO_IN + W_IN, WO_KVB = WO_QB + W_QB, WO_BR = WO_KVB + W_KVB, WO_OUT = WO_BR + W_BR,
                 WO_UP = WO_OUT + W_OUT, WO_DN = WO_UP + W_UP, W_LAYER = WO_DN + W_DN;

constexpr size_t al(size_t x) { return (x + 255) & ~(size_t)255; }
constexpr size_t OFF_W = 0;
constexpr size_t OFF_MOD = al(OFF_W + 2 * W_LAYER * 2);
constexpr size_t OFF_ROPE = al(OFF_MOD + 2 * 9 * 6144 * 4);
constexpr size_t OFF_SCAL = al(OFF_ROPE + 2048 * 4);
constexpr size_t OFF_CTR = al(OFF_SCAL + 256);
constexpr size_t OFF_BAR = al(OFF_CTR + 256);
constexpr size_t OFF_SSQ = al(OFF_BAR + 3456 * 4);
constexpr size_t OFF_H = al(OFF_SSQ + (size_t)TG * 16 * 4);
constexpr size_t OFF_DQ = al(OFF_H + (size_t)TG * LDH * 2);
constexpr size_t OFF_RQ = al(OFF_DQ + (size_t)TG * LDO * 2);
constexpr size_t OFF_RK = al(OFF_RQ + (size_t)TG * 256 * 2);
constexpr size_t OFF_RKT = al(OFF_RK + (size_t)TG * 256 * 2);
constexpr size_t OFF_RVT = al(OFF_RKT + (size_t)TG * 256 * 2);
constexpr size_t OFF_RG = al(OFF_RVT + (size_t)TG * 512 * 2);
constexpr size_t OFF_MQ = al(OFF_RG + (size_t)TG * 512 * 2);
constexpr size_t OFF_OM = al(OFF_MQ + (size_t)TG * 768 * 2);
constexpr size_t OFF_ORR = al(OFF_OM + (size_t)TG * LDO * 2);
constexpr size_t OFF_MQA = al(OFF_ORR + (size_t)TG * LDO * 2);
constexpr size_t OFF_MKVA = al(OFF_MQA + (size_t)TG * 384 * 2);
constexpr size_t OFF_MKR = al(OFF_MKVA + (size_t)TG * 256 * 2);
constexpr size_t OFF_CKVA = al(OFF_MKR + (size_t)TG * 64 * 2);
constexpr size_t OFF_CKR = al(OFF_CKVA + 2048ull * 256 * 2);
constexpr size_t OFF_DK = al(OFF_CKR + 2048ull * 64 * 2);
constexpr size_t OFF_DVT = al(OFF_DK + (size_t)KVR * 512 * 2);
constexpr size_t OFF_MK = al(OFF_DVT + (size_t)KVR * 512 * 2);
constexpr size_t OFF_MVT = al(OFF_MK + (size_t)KVR * 768 * 2);
constexpr size_t OFF_U = al(OFF_MVT + (size_t)KVR * 512 * 2);
constexpr size_t OFF_O0 = al(OFF_U + 640ull * 2 * 8192 * 4);
constexpr size_t OFF_END = al(OFF_O0 + 640ull * 64 * 256 * 4);
constexpr size_t OFF_MERGED = OFF_DK;
constexpr size_t OFF_UMLP = OFF_DQ;
static_assert((size_t)TG * LDM * 2 <= OFF_MK - OFF_DK, "merged alias");
static_assert((size_t)TG * LDU * 2 <= OFF_DK - OFF_DQ, "umlp alias");
static_assert(OFF_END <= 512ull * 1024 * 1024, "workspace");

constexpr size_t O_YP = 0, O_YS = 4194304, O_NDK = 37748736, O_NDV = 41943040, O_NCKV = 46137344, O_NKR = 48234496, O_NSR = 48758784;

struct Params {
  const float* in[30];
  float* out;
  char* ws;
};
enum { I_XP = 0, I_XS, I_CDK, I_CDV, I_CCKV, I_CKR, I_SR, I_C, I_CCTX, I_WMOD, I_BMOD, I_N1, I_N2, I_WIN, I_DQN, I_DKN, I_DLAM,
       I_DSUB, I_RDEC, I_RGN, I_QAN, I_WQB, I_KVAN, I_WKVB, I_MQN, I_MKN, I_WBR, I_WOUT, I_WUP, I_WDN };

struct Tok { int ctx, b, n, cond, bl, kvrow; size_t xrow; };
DI Tok tokinfo(int g, int m) {
  Tok t;
  if (m < TLG) { int tl = g * TLG + m; t.ctx = 0; t.b = tl >> 12; t.n = tl & 4095; t.cond = 1 + t.b; t.xrow = tl; t.bl = m >> 12; t.kvrow = t.bl * 4608 + t.n; }
  else { int tc = m - TLG; t.ctx = 1; t.b = tc >> 8; t.n = tc & 255; t.cond = 0; t.xrow = tc; t.bl = 0; t.kvrow = 18432 + tc; }
  return t;
}
DI size_t vt_base(const Tok& t) { return t.ctx ? (4ull * 512 * 4608 + (size_t)t.b * 512 * 256) : ((size_t)t.bl * 512 * 4608); }
DI int vt_L(const Tok& t) { return t.ctx ? 256 : 4608; }
DI size_t rvt_base(const Tok& t) { return t.ctx ? (4ull * 512 * 4096 + (size_t)t.b * 512 * 256) : ((size_t)t.bl * 512 * 4096); }
DI size_t rkt_base(const Tok& t) { return t.ctx ? (4ull * 256 * 4096 + (size_t)t.b * 256 * 256) : ((size_t)t.bl * 256 * 4096); }
DI int r_L(const Tok& t) { return t.ctx ? 256 : 4096; }

DI int opaque_tid() { int t = threadIdx.x; asm volatile("" : "+v"(t)); return t; }
DI int perm23(int r) { return (r & 0x13) | ((r & 4) << 1) | ((r & 8) >> 1); }
DI float wave_half_sum(float v) { return v + __shfl_xor(v, 32); }


#define XB_TMO      128
#define XB_XCNT(j)  (256  + 64 * (j))
#define XB_XSUB(j)  (1280 + 64 * (j))
#define XB_XGEN(j)  (2304 + 64 * (j))
#define XB_TOP      3328
#define XB_TOPGEN   3392
#define XCD_BAR_WORDS 3456
#define XB_SPIN_CAP (1u << 18)
DI unsigned xb_ld(unsigned* p) { return __hip_atomic_load(p, __ATOMIC_RELAXED, __HIP_MEMORY_SCOPE_AGENT); }
DI unsigned xb_add(unsigned* p, unsigned v) { return __hip_atomic_fetch_add(p, v, __ATOMIC_RELAXED, __HIP_MEMORY_SCOPE_AGENT); }
DI unsigned xb_xcc_id() { return (unsigned)__builtin_amdgcn_s_getreg((3 << 11) | 20) & 0xFu; }
#define XB_SPIN(cond, bar) do { unsigned _sp = 0; while (cond) { __builtin_amdgcn_s_sleep(1); \
    if ((++_sp & 255u) == 0u) { if (xb_ld(&(bar)[XB_TMO])) break; if (_sp > XB_SPIN_CAP) { atomicAdd(&(bar)[XB_TMO], 1u); break; } } } } while (0)
struct XcdBarrier { unsigned* bar; unsigned x; volatile unsigned* st; };
DI XcdBarrier xcd_barrier_post(unsigned* bar, volatile unsigned* st) {
  XcdBarrier b; b.bar = bar; b.x = xb_xcc_id(); b.st = st;
  if (threadIdx.x == 0) (void)xb_add(&bar[XB_XCNT(b.x)], 1u);
  return b;
}
DI void xcd_barrier_complete(unsigned* bar, unsigned x, unsigned& nloc, unsigned& nx) {
  const unsigned G = gridDim.x * gridDim.y * gridDim.z;
  unsigned sum, cnt, mine, sp = 0u;
  for (;;) {
    sum = 0u; cnt = 0u; mine = 0u;
#pragma unroll
    for (unsigned j = 0; j < 16; ++j) { const unsigned c = xb_ld(&bar[XB_XCNT(j)]); sum += c; cnt += (c > 0u) ? 1u : 0u; mine = (j == x) ? c : mine; }
    if (sum == G) break;
    __builtin_amdgcn_s_sleep(1);
    if ((++sp & 255u) == 0u) { if (xb_ld(&bar[XB_TMO])) break; if (sp > XB_SPIN_CAP) { atomicAdd(&bar[XB_TMO], 1u); break; } }
  }
  nloc = mine > 0u ? mine : 1u; nx = cnt > 0u ? cnt : 1u;
}
DI void xcd_barrier(const XcdBarrier& b) {
  asm volatile("s_waitcnt vmcnt(0)" ::: "memory");
  __syncthreads();
  if (threadIdx.x == 0) {
    unsigned* bar = b.bar;
    __builtin_amdgcn_s_waitcnt(0);
    unsigned nloc = b.st[0], nx = b.st[1];
    if (nloc == 0u) { xcd_barrier_complete(bar, b.x, nloc, nx); b.st[0] = nloc; b.st[1] = nx; }
    const unsigned old = xb_add(&bar[XB_XSUB(b.x)], 1u);
    const unsigned gen = old / nloc;
    if (old + 1u == (gen + 1u) * nloc) {
      __builtin_amdgcn_fence(__ATOMIC_RELEASE, "agent");
      asm volatile("s_waitcnt vmcnt(0)" ::: "memory");
      const unsigned og = xb_add(&bar[XB_TOP], 1u);
      const unsigned tg = og / nx;
      if (og + 1u == (tg + 1u) * nx) xb_add(&bar[XB_TOPGEN], 1u);
      else XB_SPIN(xb_ld(&bar[XB_TOPGEN]) == tg, bar);
      __builtin_amdgcn_fence(__ATOMIC_ACQUIRE, "agent");
      xb_add(&bar[XB_XGEN(b.x)], 1u);
      asm volatile("s_waitcnt vmcnt(0)" ::: "memory");
    } else {
      XB_SPIN(xb_ld(&bar[XB_XGEN(b.x)]) == gen, bar);
      __builtin_amdgcn_fence(__ATOMIC_ACQUIRE, "agent");
      asm volatile("s_waitcnt vmcnt(0)" ::: "memory");
    }
  }
  __syncthreads();
}

template <int BK> DI int lds_sw(int row) { return BK == 32 ? ((row >> 2) & 3) : ((row >> 1) & 7); }
template <int WT, int WF, int TT, int FT, int BK = 64, int D = 2>
DI void gemm_mainloop(const bf16_t* __restrict__ At, int lda, const bf16_t* __restrict__ Bf, int ldb, int K, f32x16 (&acc)[TT][FT], char* smem) {
  constexpr int BM = WT * TT * 32, BN = WF * FT * 32, LS = BK, CPR = BK / 8, RPP = 256 / CPR, NA = BM / RPP, NB = BN / RPP, STAGE = (BM + BN) * LS, KS = BK / 16;
  static_assert(2 * STAGE * 2 <= 73728, "LDS stages");
  static_assert(D == 1 || D == 2 || D == 4, "depth");
  const int tid = opaque_tid(), lane = tid & 63, wave = tid >> 6, wt = wave / WF, wf = wave % WF, lr = lane & 31, lh = lane >> 5;
  const int c8 = (tid % CPR) * 8, r0 = tid / CPR;
  const bf16_t* ap = At + (size_t)r0 * lda + c8;
  const bf16_t* bp = Bf + (size_t)r0 * ldb + c8;
  bf16_t* wA = (bf16_t*)smem + r0 * LS + (((tid % CPR) ^ lds_sw<BK>(r0)) * 8);
  bf16_t* wB = wA + BM * LS;
  int rof[KS];
#pragma unroll
  for (int ks = 0; ks < KS; ++ks) rof[ks] = ((ks * 2 + lh) ^ lds_sw<BK>(lr)) * 8;
  const bf16_t* rB = (const bf16_t*)smem + BM * LS + (wf * FT * 32 + lr) * LS;
  const bf16_t* rA = (const bf16_t*)smem + (wt * TT * 32 + lr) * LS;
  u32x4 ra[D][NA], rb[D][NB];
  const int nk = K / BK;
#pragma unroll
  for (int i = 0; i < NA; ++i) ra[0][i] = *(const u32x4*)(ap + (size_t)i * RPP * lda);
#pragma unroll
  for (int i = 0; i < NB; ++i) rb[0][i] = *(const u32x4*)(bp + (size_t)i * RPP * ldb);
#pragma unroll
  for (int i = 0; i < NA; ++i) *(u32x4*)(wA + RPP * i * LS) = ra[0][i];
#pragma unroll
  for (int i = 0; i < NB; ++i) *(u32x4*)(wB + RPP * i * LS) = rb[0][i];
#pragma unroll
  for (int d = 0; d < D; ++d) {
    if (1 + d < nk) {
      const int ko = (1 + d) * BK;
#pragma unroll
      for (int i = 0; i < NA; ++i) ra[d][i] = *(const u32x4*)(ap + (size_t)i * RPP * lda + ko);
#pragma unroll
      for (int i = 0; i < NB; ++i) rb[d][i] = *(const u32x4*)(bp + (size_t)i * RPP * ldb + ko);
    }
  }
  __syncthreads();
  for (int kb = 0; kb < nk; kb += D) {
#pragma unroll
    for (int j = 0; j < D; ++j) {
      const int kt = kb + j;
      const int so = (D == 1 ? (kt & 1) : (j & 1)) * STAGE;
#pragma unroll
      for (int ks = 0; ks < KS; ++ks) {
        bf16x8 fa[FT], tb[TT];
#pragma unroll
        for (int ft = 0; ft < FT; ++ft) fa[ft] = *(const bf16x8*)(rB + so + ft * 32 * LS + rof[ks]);
#pragma unroll
        for (int tt = 0; tt < TT; ++tt) tb[tt] = *(const bf16x8*)(rA + so + tt * 32 * LS + rof[ks]);
#pragma unroll
        for (int tt = 0; tt < TT; ++tt)
#pragma unroll
          for (int ft = 0; ft < FT; ++ft) acc[tt][ft] = MFMA(fa[ft], tb[tt], acc[tt][ft]);
      }
      if (kt + 1 < nk) {
        const int wo = STAGE - so;
#pragma unroll
        for (int i = 0; i < NA; ++i) *(u32x4*)(wA + wo + RPP * i * LS) = ra[j][i];
#pragma unroll
        for (int i = 0; i < NB; ++i) *(u32x4*)(wB + wo + RPP * i * LS) = rb[j][i];
        if (kt + 1 + D < nk) {
          const int ko = (kt + 1 + D) * BK;
#pragma unroll
          for (int i = 0; i < NA; ++i) ra[j][i] = *(const u32x4*)(ap + (size_t)i * RPP * lda + ko);
#pragma unroll
          for (int i = 0; i < NB; ++i) rb[j][i] = *(const u32x4*)(bp + (size_t)i * RPP * ldb + ko);
        }
      }
      __syncthreads();
    }
  }
}


template <int NT>
DI bool tile_map(int it, int MT, int& mt, int& nt) {
  const int G = gridDim.x, b = blockIdx.x;
  if ((G & 7) != 0) { const int t = b + it * G; mt = t / NT; nt = t % NT; return t < MT * NT; }
  const int x = b & 7, q = (b >> 3) + it * (G >> 3);
  const int bq = q / (NT * 4), rem = q % (NT * 4);
  const int band = x + 8 * bq;
  mt = band * 4 + (rem & 3); nt = rem >> 2;
  return band * 4 < MT;
}

template <int TT, int FT>
DI void zero_acc(f32x16 (&acc)[TT][FT]) {
#pragma unroll
  for (int a = 0; a < TT; ++a)
#pragma unroll
    for (int b = 0; b < FT; ++b)
#pragma unroll
      for (int i = 0; i < 16; ++i) acc[a][b][i] = 0.f;
}

DI void store_sub_bf16(bf16_t* dst, const float (&v)[16], int lh) {
#pragma unroll
  for (int q = 0; q < 4; ++q) {
    uint2 u; u.x = pk2(v[q * 4 + 0], v[q * 4 + 1]); u.y = pk2(v[q * 4 + 2], v[q * 4 + 3]);
    *(uint2*)(dst + q * 8 + lh * 4) = u;
  }
}
DI void store_sub_f32(float* dst, const float (&v)[16], int lh) {
#pragma unroll
  for (int q = 0; q < 4; ++q) *(float4*)(dst + q * 8 + lh * 4) = make_float4(v[q * 4 + 0], v[q * 4 + 1], v[q * 4 + 2], v[q * 4 + 3]);
}
DI void store_sub_T(bf16_t* dstT, size_t L, const float (&v)[16], int lh) {
#pragma unroll
  for (int i = 0; i < 16; ++i) dstT[(size_t)((i & 3) + 8 * (i >> 2) + 4 * lh) * L] = f2bf(v[i]);
}
DI void rope_sub(float (&v)[16], int pos, int lh, const float* tab) {
#pragma unroll
  for (int q = 0; q < 2; ++q) {
    const float4 c = *(const float4*)(tab + pos * 16 + q * 8 + lh * 4);
    const float4 s = *(const float4*)(tab + 1024 + pos * 16 + q * 8 + lh * 4);
    const float cc[4] = {c.x, c.y, c.z, c.w}, ss[4] = {s.x, s.y, s.z, s.w};
#pragma unroll
    for (int e = 0; e < 4; ++e) {
      const float x1 = v[q * 4 + e], x2 = v[q * 4 + e + 8];
      v[q * 4 + e] = x1 * cc[e] - x2 * ss[e];
      v[q * 4 + e + 8] = x2 * cc[e] + x1 * ss[e];
    }
  }
}

DI void transpose_tile(const float* __restrict__ src, bf16_t* __restrict__ dst, int K, int N, int tile, char* smem) {
  const int ldk = K + 64;
  float* s = (float*)smem;
  const int tid_ = opaque_tid();
  const int tn = N >> 6;
  const int k0 = (tile / tn) * 64, n0 = (tile % tn) * 64;
  for (int i = tid_; i < 4096; i += 256) { const int r = i >> 6, c = i & 63; s[r * 65 + c] = src[(size_t)(k0 + r) * N + n0 + c]; }
  __syncthreads();
  for (int i = tid_; i < 512; i += 256) {
    const int n = i >> 3, kc = (i & 7) * 8;
    uint4 v;
    v.x = pk2(s[(kc + 0) * 65 + n], s[(kc + 1) * 65 + n]);
    v.y = pk2(s[(kc + 2) * 65 + n], s[(kc + 3) * 65 + n]);
    v.z = pk2(s[(kc + 4) * 65 + n], s[(kc + 5) * 65 + n]);
    v.w = pk2(s[(kc + 6) * 65 + n], s[(kc + 7) * 65 + n]);
    *(uint4*)(dst + (size_t)(n0 + n) * ldk + k0 + kc) = v;
  }
  __syncthreads();
}

DI void mod_item(const Params& p, int item, char* smem) {
  const int tid = threadIdx.x, lane = tid & 63, wave = tid >> 6;
  const int l = item / 96, n0 = (item % 96) * 64;
  float* sv = (float*)smem;
  for (int i = tid; i < 9 * 1024; i += 256) {
    const int c = i >> 10, k = i & 1023;
    const float v = (c == 0) ? p.in[I_CCTX][k] : p.in[I_C][(c - 1) * 1024 + k];
    sv[i] = v / (1.f + expf(-v));
  }
  __syncthreads();
  float acc[9];
#pragma unroll
  for (int c = 0; c < 9; ++c) acc[c] = 0.f;
  const float* w = p.in[I_WMOD] + (size_t)l * 1024 * 6144 + n0 + lane;
  const int kb = wave * 256;
#pragma unroll 4
  for (int k = kb; k < kb + 256; ++k) {
    const float wv = w[(size_t)k * 6144];
#pragma unroll
    for (int c = 0; c < 9; ++c) acc[c] += sv[c * 1024 + k] * wv;
  }
  float* red = sv + 9 * 1024;
#pragma unroll
  for (int c = 0; c < 9; ++c) red[(wave * 9 + c) * 64 + lane] = acc[c];
  __syncthreads();
  float* mod = (float*)(p.ws + OFF_MOD);
  for (int i = tid; i < 9 * 64; i += 256) {
    const int c = i >> 6, n = i & 63;
    float s = red[(0 * 9 + c) * 64 + n] + red[(1 * 9 + c) * 64 + n] + red[(2 * 9 + c) * 64 + n] + red[(3 * 9 + c) * 64 + n];
    s += p.in[I_BMOD][l * 6144 + n0 + n];
    mod[(size_t)(l * 9 + c) * 6144 + n0 + n] = s;
  }
  __syncthreads();
}

constexpr int W_TILES = 1712 + 72 + 64 + 384 + 256 + 1024 + 1024;
DI void weight_tile(const Params& p, int l, int t, char* smem) {
  bf16_t* W = (bf16_t*)(p.ws + OFF_W);
  bf16_t* Wl = W + (size_t)l * W_LAYER;
  const float* src; bf16_t* dst; int K, N;
  if (t < 1712) { src = p.in[I_WIN] + (size_t)l * 6848 * 1024; dst = Wl + WO_IN; K = 1024; N = 6848; }
  else if ((t -= 1712) < 72) { src = p.in[I_WQB] + (size_t)l * 768 * 384; dst = Wl + WO_QB; K = 384; N = 768; }
  else if ((t -= 72) < 64) { src = p.in[I_WKVB] + (size_t)l * 1024 * 256; dst = Wl + WO_KVB; K = 256; N = 1024; }
  else if ((t -= 64) < 384) { const int i = t / 128; t -= i * 128; src = p.in[I_WBR] + (size_t)l * 3 * 512 * 1024 + (size_t)i * 512 * 1024; dst = Wl + WO_BR + (size_t)i * 1024 * LWBR; K = 512; N = 1024; }
  else if ((t -= 384) < 256) { src = p.in[I_WOUT] + (size_t)l * 1024 * 1024; dst = Wl + WO_OUT; K = 1024; N = 1024; }
  else if ((t -= 256) < 1024) { src = p.in[I_WUP] + (size_t)l * 1024 * 4096; dst = Wl + WO_UP; K = 1024; N = 4096; }
  else { t -= 1024; src = p.in[I_WDN] + (size_t)l * 4096 * 1024; dst = Wl + WO_DN; K = 4096; N = 1024; }
  transpose_tile(src, dst, K, N, t, smem);
}

DI void prep_phase(const Params& p, char* smem) {
  bf16_t* W = (bf16_t*)(p.ws + OFF_W);
  const int tid = threadIdx.x;
  constexpr int N_MOD = 192;
  constexpr int tiles_layer = 1712 + 72 + 64 + 384 + 256 + 1024 + 1024;
  const int total = 1 + N_MOD + tiles_layer;
  for (int item = blockIdx.x; item < total; item += gridDim.x) {
    if (item == 0) {
      float* tab = (float*)(p.ws + OFF_ROPE);
      for (int i = tid; i < 1024; i += 256) {
        const int pos = i >> 4, j = i & 15;
        const float inv = exp2f(-(float)j * (13.287712379549449f / 16.f));
        const float a = (float)pos * inv;
        tab[i] = cosf(a); tab[1024 + i] = sinf(a);
      }
      if (tid < 2) {
        const float* lm = p.in[I_DLAM] + tid * 256;
        float s1 = 0.f, s2 = 0.f;
        for (int k = 0; k < 64; ++k) { s1 += lm[k] * lm[64 + k]; s2 += lm[128 + k] * lm[192 + k]; }
        const float li = 0.8f - 0.6f * expf(-0.3f * (float)tid);
        ((float*)(p.ws + OFF_SCAL))[tid] = expf(s1) - expf(s2) + li;
      }
    } else if (item <= N_MOD) {
      mod_item(p, item - 1, smem);
    } else {
      weight_tile(p, 0, item - 1 - N_MOD, smem);
    }
  }
}

DI void rownorm_phase(const Params& p, int g, int l, int which) {
  const float* xin_p = p.in[I_XP]; const float* xin_s = p.in[I_XS];
  asm volatile("" : "+s"(xin_p), "+s"(xin_s));
  const int Tg = g == 0 ? TG : TLG;
  const int tid_ = opaque_tid();
  const int lane = tid_ & 63, wave = tid_ >> 6;
  const float* mod = (const float*)(p.ws + OFF_MOD);
  bf16_t* H = (bf16_t*)(p.ws + OFF_H);
  const float* gain = p.in[which ? I_N2 : I_N1] + l * 1024;
  for (int m = blockIdx.x * 4 + wave; m < Tg; m += gridDim.x * 4) {
    const Tok t = tokinfo(g, m);
    const float* xr;
    if (which == 0 && l == 0) xr = (t.ctx ? xin_p : xin_s) + t.xrow * 1024;
    else xr = p.out + (t.ctx ? O_YP : O_YS) + t.xrow * 1024;
    float4 v[4];
    float ss = 0.f;
#pragma unroll
    for (int i = 0; i < 4; ++i) { v[i] = ((const float4*)xr)[lane + 64 * i]; ss += v[i].x * v[i].x + v[i].y * v[i].y + v[i].z * v[i].z + v[i].w * v[i].w; }
#pragma unroll
    for (int o = 32; o >= 1; o >>= 1) ss += __shfl_xor(ss, o);
    const float rstd = rsqrtf(ss * (1.f / 1024.f) + EPS);
    const float* mrow = mod + (size_t)(l * 9 + t.cond) * 6144;
    const float* sh = mrow + (which ? 3072 : 0);
    const float* sc = mrow + (which ? 4096 : 1024);
#pragma unroll
    for (int i = 0; i < 4; ++i) {
      const int k = (lane + 64 * i) * 4;
      const float4 gg = *(const float4*)(gain + k), s4 = *(const float4*)(sc + k), h4 = *(const float4*)(sh + k);
      uint2 u;
      u.x = pk2(v[i].x * rstd * gg.x * (1.f + s4.x) + h4.x, v[i].y * rstd * gg.y * (1.f + s4.y) + h4.y);
      u.y = pk2(v[i].z * rstd * gg.z * (1.f + s4.z) + h4.z, v[i].w * rstd * gg.w * (1.f + s4.w) + h4.w);
      *(uint2*)(H + (size_t)m * LDH + k) = u;
    }
  }
}

DI void cache_convert(const Params& p, int g, int l, char* smem) {
  int nt = gridDim.x * 256; asm volatile("" : "+s"(nt));
  const int gt = blockIdx.x * 256 + opaque_tid();
  bf16_t* DK = (bf16_t*)(p.ws + OFF_DK);
  bf16_t* DVT = (bf16_t*)(p.ws + OFF_DVT);
  bf16_t* CKVA = (bf16_t*)(p.ws + OFF_CKVA);
  bf16_t* CKR = (bf16_t*)(p.ws + OFF_CKR);
  for (int i = gt; i < 4 * 512 * 128; i += nt) {
    const int c4 = (i & 127) * 4, pp = (i >> 7) & 511, bl = i >> 16;
    const float4 v = *(const float4*)(p.in[I_CDK] + ((size_t)((g * 4 + bl) * 2 + l) * 512 + pp) * 512 + c4);
    uint2 u; u.x = pk2(v.x, v.y); u.y = pk2(v.z, v.w);
    *(uint2*)(DK + (size_t)(bl * 4608 + 4096 + pp) * 512 + c4) = u;
  }
  {
    float* st = (float*)smem;
    const int tid = opaque_tid();
    for (int item = blockIdx.x; item < 4 * 8 * 8; item += gridDim.x) {
      const int bl = item >> 6, pt = (item >> 3) & 7, ct = item & 7;
      const float* src = p.in[I_CDV] + ((size_t)((g * 4 + bl) * 2 + l) * 512 + pt * 64) * 512 + ct * 64;
      for (int i = tid; i < 4096; i += 256) { const int r = i >> 6, c = i & 63; st[r * 65 + c] = src[(size_t)r * 512 + c]; }
      __syncthreads();
      for (int i = tid; i < 512; i += 256) {
        const int c = i >> 3, pc = (i & 7) * 8;
        uint4 v;
        v.x = pk2(st[(pc + 0) * 65 + c], st[(pc + 1) * 65 + c]); v.y = pk2(st[(pc + 2) * 65 + c], st[(pc + 3) * 65 + c]);
        v.z = pk2(st[(pc + 4) * 65 + c], st[(pc + 5) * 65 + c]); v.w = pk2(st[(pc + 6) * 65 + c], st[(pc + 7) * 65 + c]);
        *(uint4*)(DVT + (size_t)bl * 512 * 4608 + (size_t)(ct * 64 + c) * 4608 + 4096 + pt * 64 + pc) = v;
      }
      __syncthreads();
    }
  }
  for (int i = gt; i < 4 * 512 * 64; i += nt) {
    const int c4 = (i & 63) * 4, pp = (i >> 6) & 511, bl = i >> 15;
    const float4 v = *(const float4*)(p.in[I_CCKV] + ((size_t)((g * 4 + bl) * 2 + l) * 512 + pp) * 256 + c4);
    uint2 u; u.x = pk2(v.x, v.y); u.y = pk2(v.z, v.w);
    *(uint2*)(CKVA + (size_t)(bl * 512 + pp) * 256 + c4) = u;
  }
  for (int i = gt; i < 4 * 512 * 16; i += nt) {
    const int c4 = (i & 15) * 4, pp = (i >> 4) & 511, bl = i >> 13;
    const float4 v = *(const float4*)(p.in[I_CKR] + ((size_t)((g * 4 + bl) * 2 + l) * 512 + pp) * 64 + c4);
    uint2 u; u.x = pk2(v.x, v.y); u.y = pk2(v.z, v.w);
    *(uint2*)(CKR + (size_t)(bl * 512 + pp) * 64 + c4) = u;
  }
}

DI void gemm1_phase(const Params& p, int g, int l, char* smem) {
  const int Tg = g == 0 ? TG : TLG;
  const int MT = Tg / 128;
  constexpr int NT = 30;
  const bf16_t* H = (const bf16_t*)(p.ws + OFF_H);
  const bf16_t* WinT = (const bf16_t*)(p.ws + OFF_W) + (size_t)l * W_LAYER + WO_IN;
  const float* tab = (const float*)(p.ws + OFF_ROPE);
  float* SSQ = (float*)(p.ws + OFF_SSQ);
  for (int it = 0;; ++it) {
    int mt, nt;
    if (!tile_map<NT>(it, MT, mt, nt)) break;
    const int tid = opaque_tid(), lane = tid & 63, wave = tid >> 6, wt = wave >> 1, wf = wave & 1, lr = lane & 31, lh = lane >> 5;
    const int m0 = mt * 128, n0 = nt * 128;
    f32x16 acc[2][2];
    zero_acc<2, 2>(acc);
    gemm_mainloop<2, 2, 2, 2, 64, 1>(H + (size_t)m0 * LDH, LDH, WinT + (size_t)n0 * LW1, LW1, 1024, acc, smem);
    const int F = n0 + wf * 64;
    if (F >= NZ) continue;
#pragma unroll
    for (int tt = 0; tt < 2; ++tt) {
      const int m = m0 + wt * 64 + tt * 32 + lr;
      const Tok t = tokinfo(g, m);
      float v[2][16];
#pragma unroll
      for (int ft = 0; ft < 2; ++ft)
#pragma unroll
        for (int i = 0; i < 16; ++i) v[ft][i] = acc[tt][ft][i];
      if (F < 1024) {
        float ss = 0.f;
#pragma unroll
        for (int ft = 0; ft < 2; ++ft)
#pragma unroll
          for (int i = 0; i < 16; ++i) ss += v[ft][i] * v[ft][i];
        ss = wave_half_sum(ss);
        const float rstd = rsqrtf(ss * (1.f / 64.f) + EPS);
        const float* gn = p.in[F < 512 ? I_DQN : I_DKN] + l * 64;
#pragma unroll
        for (int ft = 0; ft < 2; ++ft)
#pragma unroll
          for (int i = 0; i < 16; ++i) v[ft][i] *= rstd * gn[ft * 32 + (i & 3) + 8 * (i >> 2) + 4 * lh];
        if (t.ctx) {
          if (F >= 512) {
            float* o = p.out + O_NDK + ((size_t)(t.b * 2 + l) * 256 + t.n) * 512 + (F - 512);
            store_sub_f32(o, v[0], lh); store_sub_f32(o + 32, v[1], lh);
          }
        } else {
          rope_sub(v[0], t.n >> 6, lh, tab); rope_sub(v[1], t.n & 63, lh, tab);
        }
        bf16_t* d = (F < 512) ? ((bf16_t*)(p.ws + OFF_DQ) + (size_t)m * LDO + F) : ((bf16_t*)(p.ws + OFF_DK) + (size_t)t.kvrow * 512 + (F - 512));
        store_sub_bf16(d, v[0], lh); store_sub_bf16(d + 32, v[1], lh);
      } else if (F < 1536) {
        const int c = F - 1024;
        if (t.ctx) {
          float* o = p.out + O_NDV + ((size_t)(t.b * 2 + l) * 256 + t.n) * 512 + c;
          store_sub_f32(o, v[0], lh); store_sub_f32(o + 32, v[1], lh);
        }
        const int L = vt_L(t);
        bf16_t* d = (bf16_t*)(p.ws + OFF_DVT) + vt_base(t) + (size_t)c * L + t.n;
        store_sub_T(d, L, v[0], lh); store_sub_T(d + (size_t)32 * L, L, v[1], lh);
      } else if (F < 2048) {
        const bool isk = F >= 1792;
        if (isk) {
#pragma unroll
          for (int ft = 0; ft < 2; ++ft)
#pragma unroll
            for (int i = 0; i < 16; ++i) v[ft][i] *= 0.125f;
        }
        if (!t.ctx) { rope_sub(v[0], t.n >> 6, lh, tab); rope_sub(v[1], t.n & 63, lh, tab); }
        if (!isk) {
          bf16_t* d = (bf16_t*)(p.ws + OFF_RQ) + (size_t)m * 256 + (F - 1536);
          store_sub_bf16(d, v[0], lh); store_sub_bf16(d + 32, v[1], lh);
        } else {
          bf16_t* d = (bf16_t*)(p.ws + OFF_RK) + (size_t)m * 256 + (F - 1792);
          store_sub_bf16(d, v[0], lh); store_sub_bf16(d + 32, v[1], lh);
          const int L = r_L(t);
          bf16_t* dT = (bf16_t*)(p.ws + OFF_RKT) + rkt_base(t) + (size_t)(F - 1792) * L + t.n;
          store_sub_T(dT, L, v[0], lh); store_sub_T(dT + (size_t)32 * L, L, v[1], lh);
        }
      } else if (F < 2560) {
        const int L = r_L(t);
        bf16_t* dT = (bf16_t*)(p.ws + OFF_RVT) + rvt_base(t) + (size_t)(F - 2048) * L + t.n;
        store_sub_T(dT, L, v[0], lh); store_sub_T(dT + (size_t)32 * L, L, v[1], lh);
      } else if (F < 3072) {
        bf16_t* d = (bf16_t*)(p.ws + OFF_RG) + (size_t)m * 512 + (F - 2560);
        store_sub_bf16(d, v[0], lh); store_sub_bf16(d + 32, v[1], lh);
      } else if (F < 3712) {
        const bool isq = F < 3456;
        float ss = 0.f;
#pragma unroll
        for (int ft = 0; ft < 2; ++ft)
#pragma unroll
          for (int i = 0; i < 16; ++i) ss += v[ft][i] * v[ft][i];
        ss = wave_half_sum(ss);
        const int c = isq ? (F - 3072) : (F - 3456);
        if (lh == 0) SSQ[(size_t)m * 16 + (isq ? 0 : 6) + (c >> 6)] = ss;
        const float* gn = p.in[isq ? I_QAN : I_KVAN] + l * (isq ? 384 : 256) + c;
#pragma unroll
        for (int ft = 0; ft < 2; ++ft)
#pragma unroll
          for (int i = 0; i < 16; ++i) v[ft][i] *= gn[ft * 32 + (i & 3) + 8 * (i >> 2) + 4 * lh];
        bf16_t* d = isq ? ((bf16_t*)(p.ws + OFF_MQA) + (size_t)m * 384 + c) : ((bf16_t*)(p.ws + OFF_MKVA) + (size_t)m * 256 + c);
        store_sub_bf16(d, v[0], lh); store_sub_bf16(d + 32, v[1], lh);
      } else {
        if (t.ctx) {
          float* o = p.out + O_NKR + ((size_t)(t.b * 2 + l) * 256 + t.n) * 64;
          store_sub_f32(o, v[0], lh); store_sub_f32(o + 32, v[1], lh);
        }
        bf16_t* d = (bf16_t*)(p.ws + OFF_MKR) + (size_t)m * 64;
        store_sub_bf16(d, v[0], lh); store_sub_bf16(d + 32, v[1], lh);
      }
    }
  }
}

DI void mq_tile(const Params& p, int g, int l, int mt, int head, char* smem) {
  const int tid = opaque_tid(), lane = tid & 63, wave = tid >> 6, lr = lane & 31, lh = lane >> 5;
  const bf16_t* A = (const bf16_t*)(p.ws + OFF_MQA) + (size_t)mt * 128 * 384;
  const bf16_t* B = (const bf16_t*)(p.ws + OFF_W) + (size_t)l * W_LAYER + WO_QB + (size_t)head * 192 * LWQB;
  f32x16 acc[1][6];
  zero_acc<1, 6>(acc);
  gemm_mainloop<4, 1, 1, 6, 32, 1>(A, 384, B, LWQB, 384, acc, smem);
  const int m = mt * 128 + wave * 32 + lr;
  const Tok t = tokinfo(g, m);
  const float* SSQ = (const float*)(p.ws + OFF_SSQ) + (size_t)m * 16;
  const float rq = rsqrtf((SSQ[0] + SSQ[1] + SSQ[2] + SSQ[3] + SSQ[4] + SSQ[5]) * (1.f / 384.f) + EPS);
  float ss = 0.f;
#pragma unroll
  for (int ft = 0; ft < 6; ++ft)
#pragma unroll
    for (int i = 0; i < 16; ++i) { const float x = acc[0][ft][i] * rq; ss += x * x; }
  ss = wave_half_sum(ss);
  const float rh = rsqrtf(ss * (1.f / 192.f) + EPS) * rq;
  const float* gn = p.in[I_MQN] + l * 192;
  const float* tab = (const float*)(p.ws + OFF_ROPE);
  bf16_t* d = (bf16_t*)(p.ws + OFF_MQ) + (size_t)m * 768 + head * 192;
#pragma unroll
  for (int ft = 0; ft < 6; ++ft) {
    float v[16];
#pragma unroll
    for (int i = 0; i < 16; ++i) v[i] = acc[0][ft][i] * rh * gn[ft * 32 + (i & 3) + 8 * (i >> 2) + 4 * lh];
    if (ft >= 4 && !t.ctx) rope_sub(v, ft == 4 ? (t.n >> 6) : (t.n & 63), lh, tab);
    store_sub_bf16(d + ft * 32, v, lh);
  }
}

DI void mkv_tile(const Params& p, int g, int l, int mt, int j, bool cached, char* smem) {
  const int tid = opaque_tid(), lane = tid & 63, wave = tid >> 6, lr = lane & 31, lh = lane >> 5;
  const bf16_t* A = (const bf16_t*)(p.ws + (cached ? OFF_CKVA : OFF_MKVA)) + (size_t)mt * 128 * 256;
  const bf16_t* B = (const bf16_t*)(p.ws + OFF_W) + (size_t)l * W_LAYER + WO_KVB + (size_t)j * 128 * LWKVB;
  f32x16 acc[1][4];
  zero_acc<1, 4>(acc);
  gemm_mainloop<4, 1, 1, 4, 32, 1>(A, 256, B, LWKVB, 256, acc, smem);
  const int m = mt * 128 + wave * 32 + lr;
  const int head = j >> 1;
  int ctx = 0, kvrow, L, pos, n = 0, bb = 0;
  size_t vbase;
  float rkva = 1.f;
  if (cached) {
    const int bl = m >> 9, pp = m & 511;
    kvrow = bl * 4608 + 4096 + pp; L = 4608; pos = 4096 + pp; vbase = (size_t)bl * 512 * 4608;
  } else {
    const Tok t = tokinfo(g, m);
    ctx = t.ctx; kvrow = t.kvrow; L = vt_L(t); pos = t.n; n = t.n; bb = t.b; vbase = vt_base(t);
    const float* SSQ = (const float*)(p.ws + OFF_SSQ) + (size_t)m * 16;
    rkva = rsqrtf((SSQ[6] + SSQ[7] + SSQ[8] + SSQ[9]) * (1.f / 256.f) + EPS);
  }
  if ((j & 1) == 0) {
    const bf16_t* krp = (const bf16_t*)(p.ws + (cached ? OFF_CKR : OFF_MKR)) + (size_t)m * 64 + lh * 32;
    u32x4 krq[4];
#pragma unroll
    for (int q = 0; q < 4; ++q) krq[q] = *(const u32x4*)(krp + q * 8);
    float ss = 0.f;
#pragma unroll
    for (int ft = 0; ft < 4; ++ft)
#pragma unroll
      for (int i = 0; i < 16; ++i) { const float x = acc[0][ft][i] * rkva; ss += x * x; }
#pragma unroll
    for (int q = 0; q < 4; ++q)
#pragma unroll
      for (int e = 0; e < 4; ++e) { const float a = bflo(krq[q][e]), b = bfhi(krq[q][e]); ss += a * a + b * b; }
    ss = wave_half_sum(ss);
    const float rh = rsqrtf(ss * (1.f / 192.f) + EPS);
    const float* gn = p.in[I_MKN] + l * 192;
    bf16_t* d = (bf16_t*)(p.ws + OFF_MK) + (size_t)kvrow * 768 + head * 192;
#pragma unroll
    for (int ft = 0; ft < 4; ++ft) {
      float v[16];
#pragma unroll
      for (int i = 0; i < 16; ++i) v[i] = acc[0][ft][i] * rkva * rh * gn[ft * 32 + (i & 3) + 8 * (i >> 2) + 4 * lh];
      store_sub_bf16(d + ft * 32, v, lh);
    }
    {
      float kr[32];
#pragma unroll
      for (int q = 0; q < 4; ++q)
#pragma unroll
        for (int e = 0; e < 4; ++e) { kr[q * 8 + 2 * e] = bflo(krq[q][e]); kr[q * 8 + 2 * e + 1] = bfhi(krq[q][e]); }
#pragma unroll
      for (int q = 0; q < 32; ++q) kr[q] *= rh * gn[128 + lh * 32 + q];
      if (!cached && !ctx) {
        const float* tab = (const float*)(p.ws + OFF_ROPE);
        const int ps = lh == 0 ? (n >> 6) : (n & 63);
#pragma unroll
        for (int q = 0; q < 16; ++q) {
          const float c = tab[ps * 16 + q], sn = tab[1024 + ps * 16 + q];
          const float x1 = kr[q], x2 = kr[q + 16];
          kr[q] = x1 * c - x2 * sn; kr[q + 16] = x2 * c + x1 * sn;
        }
      }
#pragma unroll
      for (int q = 0; q < 4; ++q) {
        uint4 u;
        u.x = pk2(kr[q * 8 + 0], kr[q * 8 + 1]); u.y = pk2(kr[q * 8 + 2], kr[q * 8 + 3]);
        u.z = pk2(kr[q * 8 + 4], kr[q * 8 + 5]); u.w = pk2(kr[q * 8 + 6], kr[q * 8 + 7]);
        *(uint4*)(d + 128 + lh * 32 + q * 8) = u;
      }
    }
    if (ctx && j == 0) {
      const bf16_t* src = (const bf16_t*)(p.ws + OFF_MKVA) + (size_t)m * 256 + lh * 128;
      float* o = p.out + O_NCKV + ((size_t)(bb * 2 + l) * 256 + n) * 256 + lh * 128;
#pragma unroll 4
      for (int q = 0; q < 16; ++q) {
        const uint4 u = *(const uint4*)(src + q * 8);
        *(float4*)(o + q * 8) = make_float4(bflo(u.x) * rkva, bfhi(u.x) * rkva, bflo(u.y) * rkva, bfhi(u.y) * rkva);
        *(float4*)(o + q * 8 + 4) = make_float4(bflo(u.z) * rkva, bfhi(u.z) * rkva, bflo(u.w) * rkva, bfhi(u.w) * rkva);
      }
    }
  } else {
    bf16_t* dT = (bf16_t*)(p.ws + OFF_MVT) + vbase + (size_t)(head * 128) * L + pos;
#pragma unroll
    for (int ft = 0; ft < 4; ++ft) {
      float v[16];
#pragma unroll
      for (int i = 0; i < 16; ++i) v[i] = acc[0][ft][i] * rkva;
      store_sub_T(dT + (size_t)(ft * 32) * L, L, v, lh);
    }
  }
}

DI void retU_item(const Params& p, int l, int idx, char* smem) {
  const int tid = opaque_tid(), lane = tid & 63, wave = tid >> 6, lr = lane & 31, lh = lane >> 5;
  int head, c, L; size_t kb, vb;
  if (idx < 512) { const int bl = idx >> 7; head = (idx >> 5) & 3; c = idx & 31; L = 4096; kb = (size_t)bl * 256 * 4096; vb = (size_t)bl * 512 * 4096; }
  else { const int r = idx - 512; const int bc = r >> 3; head = (r >> 1) & 3; c = r & 1; L = 256; kb = 4ull * 256 * 4096 + (size_t)bc * 256 * 256; vb = 4ull * 512 * 4096 + (size_t)bc * 512 * 256; }
  const bf16_t* Kt = (const bf16_t*)(p.ws + OFF_RKT) + kb + (size_t)(head * 64) * L + c * 128;
  const bf16_t* Vt = (const bf16_t*)(p.ws + OFF_RVT) + vb + (size_t)(head * 128) * L + c * 128;
  const float xf = p.in[I_RDEC][l * 8 + head], xb = p.in[I_RDEC][l * 8 + 4 + head];
  const float lgf = -log1pf(expf(-xf)) * LOG2E, lgb = -log1pf(expf(-xb)) * LOG2E;
  bf16_t* sKf = (bf16_t*)smem;
  bf16_t* sKb = sKf + 64 * 136;
  bf16x8 vf[8];
#pragma unroll
  for (int ks = 0; ks < 8; ++ks) vf[ks] = *(const bf16x8*)(Vt + (size_t)(wave * 32 + lr) * L + ks * 16 + lh * 8);
  for (int i = tid; i < 1024; i += 256) {
    const int d = i >> 4, tc = (i & 15) * 8;
    const uint4 u = *(const uint4*)(Kt + (size_t)d * L + tc);
    const float x[8] = {bflo(u.x), bfhi(u.x), bflo(u.y), bfhi(u.y), bflo(u.z), bfhi(u.z), bflo(u.w), bfhi(u.w)};
    float wf_[8], wb_[8];
#pragma unroll
    for (int e = 0; e < 8; ++e) { wf_[e] = exp2f(lgf * (float)(127 - tc - e)); wb_[e] = exp2f(lgb * (float)(tc + e)); }
    uint4 a, b;
    a.x = pk2(x[0] * wf_[0], x[1] * wf_[1]); a.y = pk2(x[2] * wf_[2], x[3] * wf_[3]); a.z = pk2(x[4] * wf_[4], x[5] * wf_[5]); a.w = pk2(x[6] * wf_[6], x[7] * wf_[7]);
    b.x = pk2(x[0] * wb_[0], x[1] * wb_[1]); b.y = pk2(x[2] * wb_[2], x[3] * wb_[3]); b.z = pk2(x[4] * wb_[4], x[5] * wb_[5]); b.w = pk2(x[6] * wb_[6], x[7] * wb_[7]);
    *(uint4*)(sKf + d * 136 + tc) = a;
    *(uint4*)(sKb + d * 136 + tc) = b;
  }
  __syncthreads();
  f32x16 af[2], ab[2];
#pragma unroll
  for (int s = 0; s < 2; ++s)
#pragma unroll
    for (int i = 0; i < 16; ++i) { af[s][i] = 0.f; ab[s][i] = 0.f; }
#pragma unroll
  for (int ks = 0; ks < 8; ++ks) {
#pragma unroll
    for (int ds = 0; ds < 2; ++ds) {
      const bf16x8 bF = *(const bf16x8*)(sKf + (ds * 32 + lr) * 136 + ks * 16 + lh * 8);
      const bf16x8 bB = *(const bf16x8*)(sKb + (ds * 32 + lr) * 136 + ks * 16 + lh * 8);
      af[ds] = MFMA(vf[ks], bF, af[ds]);
      ab[ds] = MFMA(vf[ks], bB, ab[ds]);
    }
  }
  float* U = (float*)(p.ws + OFF_U) + (size_t)idx * 2 * 8192;
#pragma unroll
  for (int ds = 0; ds < 2; ++ds)
#pragma unroll
    for (int i = 0; i < 16; ++i) {
      const int e = wave * 32 + (i & 3) + 8 * (i >> 2) + 4 * lh;
      U[e * 64 + ds * 32 + lr] = af[ds][i];
      U[8192 + e * 64 + ds * 32 + lr] = ab[ds][i];
    }
  __syncthreads();
}

DI void p3_phase(const Params& p, int g, int l, char* smem) {
  const int Tg = g == 0 ? TG : TLG;
  const int MT = Tg / 128;
  const int n_mq = MT * 4, n_mkv = MT * 8, n_c = 16 * 8, n_u = g == 0 ? 640 : 512;
  const int G = gridDim.x;
  int o1 = n_mq; while (o1 >= G) o1 -= G;
  int o2 = n_mq + n_mkv; while (o2 >= G) o2 -= G;
  int o3 = n_mq + n_mkv + n_c; while (o3 >= G) o3 -= G;
  int s1 = (int)blockIdx.x - o1; if (s1 < 0) s1 += G;
  int s2 = (int)blockIdx.x - o2; if (s2 < 0) s2 += G;
  int s3 = (int)blockIdx.x - o3; if (s3 < 0) s3 += G;
  for (int t = blockIdx.x; t < n_mq; t += G) mq_tile(p, g, l, t >> 2, t & 3, smem);
  for (int t = s1; t < n_mkv; t += G) mkv_tile(p, g, l, t >> 3, t & 7, false, smem);
  for (int t = s2; t < n_c; t += G) mkv_tile(p, g, l, t >> 3, t & 7, true, smem);
  for (int t = s3; t < n_u; t += G) retU_item(p, l, t, smem);
}

DI void ret_scan_phase(const Params& p, int g, int l) {
  int nthr = gridDim.x * 256; asm volatile("" : "+s"(nthr));
  const int gt = blockIdx.x * 256 + opaque_tid();
  const int nseq_lat = 16, nseq = g == 0 ? 16 + 64 : 16;
  float* Ub = (float*)(p.ws + OFF_U);
  for (int w = gt; w < nseq * 2 * 8192; w += nthr) {
    const int el = w & 8191, dir = (w >> 13) & 1, sq = w >> 14;
    const int e = el >> 6, d = el & 63;
    int head, nc, b, ubase; bool ctx;
    if (sq < nseq_lat) { const int bl = sq >> 2; head = sq & 3; nc = 32; ctx = false; b = g * 4 + bl; ubase = (bl * 4 + head) * 32; }
    else { const int r = sq - nseq_lat; const int bc = r >> 2; head = r & 3; nc = 2; ctx = true; b = bc; ubase = 512 + (bc * 4 + head) * 2; }
    const float x = p.in[I_RDEC][l * 8 + dir * 4 + head];
    const float wgt = exp2f(-log1pf(expf(-x)) * LOG2E * 128.f);
    float R = ctx ? 0.f : p.in[I_SR][((size_t)((b * 2 + l) * 2 + dir) * 4 + head) * 8192 + d * 128 + e];
    float* u = Ub + (size_t)ubase * 2 * 8192 + dir * 8192 + el;
    if (dir == 0) {
      for (int c = 0; c < nc; ++c) { float* q = u + (size_t)c * 2 * 8192; const float t = *q; *q = R; R = wgt * R + t; }
    } else {
      for (int c = nc - 1; c >= 0; --c) { float* q = u + (size_t)c * 2 * 8192; const float t = *q; *q = R; R = wgt * R + t; }
    }
    if (ctx) p.out[O_NSR + ((size_t)((b * 2 + l) * 2 + dir) * 4 + head) * 8192 + d * 128 + e] = R;
  }
}

template <int DQK>
DI void flash_map(const bf16_t* __restrict__ Qrow, const bf16_t* __restrict__ Kb, int ldk, const bf16_t* __restrict__ Vt, int Lkv, int nkeys, float sc,
                  f32x16 (&O)[4], float& lsum, char* smem) {
  constexpr int KS = DQK / 16, KSTR = DQK + 8, NK = DQK / 32;
  const int tid = opaque_tid(), lane = tid & 63, lr = lane & 31, lh = lane >> 5;
  bf16_t* sK = (bf16_t*)smem;
  bf16_t* sV = sK + 64 * KSTR;
  bf16x8 q[KS];
#pragma unroll
  for (int ks = 0; ks < KS; ++ks) q[ks] = *(const bf16x8*)(Qrow + ks * 16 + lh * 8);
#pragma unroll
  for (int et = 0; et < 4; ++et)
#pragma unroll
    for (int i = 0; i < 16; ++i) O[et][i] = 0.f;
  float mrun = -1e30f, lrun = 0.f;
  u32x4 rk[NK], rv[4];
  const bf16_t* kp = Kb + (size_t)(tid >> 2) * ldk + (tid & 3) * 8;
  const bf16_t* vp = Vt + (size_t)(tid >> 1) * Lkv + (tid & 1) * 32;
  bf16_t* skw = sK + (tid >> 2) * KSTR + (tid & 3) * 8;
  bf16_t* svw = sV + (tid >> 1) * 72 + (tid & 1) * 32;
#pragma unroll
  for (int i = 0; i < NK; ++i) rk[i] = *(const u32x4*)(kp + i * 32);
#pragma unroll
  for (int i = 0; i < 4; ++i) rv[i] = *(const u32x4*)(vp + i * 8);
  const int nt = nkeys >> 6;
  const int prow = perm23(lr);
  for (int kt = 0; kt < nt; ++kt) {
#pragma unroll
    for (int i = 0; i < NK; ++i) *(u32x4*)(skw + i * 32) = rk[i];
#pragma unroll
    for (int i = 0; i < 4; ++i) *(u32x4*)(svw + i * 8) = rv[i];
    __syncthreads();
    if (kt + 1 < nt) {
      kp += (size_t)64 * ldk;
      vp += 64;
#pragma unroll
      for (int i = 0; i < NK; ++i) rk[i] = *(const u32x4*)(kp + i * 32);
#pragma unroll
      for (int i = 0; i < 4; ++i) rv[i] = *(const u32x4*)(vp + i * 8);
    }

    f32x16 S[2];
#pragma unroll
    for (int sub = 0; sub < 2; ++sub) {
#pragma unroll
      for (int i = 0; i < 16; ++i) S[sub][i] = 0.f;
#pragma unroll
      for (int ks = 0; ks < KS; ++ks) {
        const bf16x8 a = *(const bf16x8*)(sK + (sub * 32 + prow) * KSTR + ks * 16 + lh * 8);
        S[sub] = MFMA(a, q[ks], S[sub]);
      }

    }
    float mx = S[0][0];
#pragma unroll
    for (int i = 1; i < 16; ++i) mx = fmaxf(mx, S[0][i]);
#pragma unroll
    for (int i = 0; i < 16; ++i) mx = fmaxf(mx, S[1][i]);
    mx = fmaxf(mx, __shfl_xor(mx, 32));
    const float mnew = fmaxf(mrun, mx * sc);
    const bool moved = __builtin_amdgcn_ballot_w64(mnew > mrun) != 0ull;
    float ps = 0.f;
    f32x2_t ps2 = {0.f, 0.f};
    const f32x2_t sc2 = {sc, sc}, mn2 = {mnew, mnew};
#pragma unroll
    for (int sub = 0; sub < 2; ++sub)
#pragma unroll
      for (int i = 0; i < 16; i += 2) {
        f32x2_t x = {S[sub][i], S[sub][i + 1]};
        x = x * sc2 - mn2;
        f32x2_t e = {__builtin_amdgcn_exp2f(x.x), __builtin_amdgcn_exp2f(x.y)};
        S[sub][i] = e.x; S[sub][i + 1] = e.y;
        ps2 += e;
      }
    ps = ps2.x + ps2.y;
    if (moved) {
      const float alpha = __builtin_amdgcn_exp2f(mrun - mnew);
      lrun *= alpha;
#pragma unroll
      for (int et = 0; et < 4; ++et)
#pragma unroll
        for (int i = 0; i < 16; ++i) O[et][i] *= alpha;
    }
    mrun = mnew;
    lrun += ps;

#pragma unroll
    for (int sub = 0; sub < 2; ++sub)
#pragma unroll
      for (int s = 0; s < 2; ++s) {
        uint4 u;
        u.x = pk2(S[sub][8 * s + 0], S[sub][8 * s + 1]); u.y = pk2(S[sub][8 * s + 2], S[sub][8 * s + 3]);
        u.z = pk2(S[sub][8 * s + 4], S[sub][8 * s + 5]); u.w = pk2(S[sub][8 * s + 6], S[sub][8 * s + 7]);
        const bf16x8 pf = __builtin_bit_cast(bf16x8, u);
#pragma unroll
        for (int et = 0; et < 4; ++et) {
          const bf16x8 a = *(const bf16x8*)(sV + (et * 32 + lr) * 72 + sub * 32 + s * 16 + lh * 8);
          O[et] = MFMA(a, pf, O[et]);
        }

      }
    __syncthreads();
  }
  lsum = wave_half_sum(lrun);
}

DI void attn_mla_item(const Params& p, int l, bool ctx, int bs, int head, int qt, char* smem) {
  const int tid = opaque_tid(), lane = tid & 63, wave = tid >> 6, lr = lane & 31, lh = lane >> 5;
  const int m = (ctx ? TLG + bs * 256 : bs * 4096) + qt * 128 + wave * 32 + lr;
  const int kv0 = ctx ? 18432 + bs * 256 : bs * 4608;
  const int Lkv = ctx ? 256 : 4608;
  const size_t vb = ctx ? (4ull * 512 * 4608 + (size_t)bs * 512 * 256) : ((size_t)bs * 512 * 4608);
  const bf16_t* Q = (const bf16_t*)(p.ws + OFF_MQ) + (size_t)m * 768 + head * 192;
  const bf16_t* K = (const bf16_t*)(p.ws + OFF_MK) + (size_t)kv0 * 768 + head * 192;
  const bf16_t* Vt = (const bf16_t*)(p.ws + OFF_MVT) + vb + (size_t)(head * 128) * Lkv;
  f32x16 O[4];
  float ls;
  flash_map<192>(Q, K, 768, Vt, Lkv, Lkv, 0.07216878364870322f * LOG2E, O, ls, smem);
  const float il = 1.f / ls;
  bf16_t* d = (bf16_t*)(p.ws + OFF_OM) + (size_t)m * LDO + head * 128;
#pragma unroll
  for (int et = 0; et < 4; ++et) {
    float v[16];
#pragma unroll
    for (int i = 0; i < 16; ++i) v[i] = O[et][i] * il;
    store_sub_bf16(d + et * 32, v, lh);
  }
}

DI void attn_diff_item(const Params& p, int l, bool ctx, int bs, int head, int qt, char* smem) {
  const int tid = opaque_tid(), lane = tid & 63, wave = tid >> 6, lr = lane & 31, lh = lane >> 5;
  const int m = (ctx ? TLG + bs * 256 : bs * 4096) + qt * 128 + wave * 32 + lr;
  const int kv0 = ctx ? 18432 + bs * 256 : bs * 4608;
  const int Lkv = ctx ? 256 : 4608;
  const size_t vb = ctx ? (4ull * 512 * 4608 + (size_t)bs * 512 * 256) : ((size_t)bs * 512 * 4608);
  bf16_t* Qr = (bf16_t*)(p.ws + OFF_DQ) + (size_t)m * LDO + head * 128;
  const bf16_t* K = (const bf16_t*)(p.ws + OFF_DK) + (size_t)kv0 * 512 + head * 128;
  const bf16_t* Vt = (const bf16_t*)(p.ws + OFF_DVT) + vb + (size_t)(head * 128) * Lkv;
  const float lam = ((const float*)(p.ws + OFF_SCAL))[l];
  const float li = 0.8f - 0.6f * expf(-0.3f * (float)l);
  float* o0 = (float*)(p.ws + OFF_O0) + ((size_t)blockIdx.x * 256 + tid) * 64;
  {
    f32x16 O[4];
    float ls;
    flash_map<64>(Qr, K, 512, Vt, Lkv, Lkv, 0.125f * LOG2E, O, ls, smem);
    const float il = 1.f / ls;
#pragma unroll
    for (int et = 0; et < 4; ++et)
#pragma unroll
      for (int q = 0; q < 4; ++q)
        *(float4*)(o0 + et * 16 + q * 4) = make_float4(O[et][q * 4] * il, O[et][q * 4 + 1] * il, O[et][q * 4 + 2] * il, O[et][q * 4 + 3] * il);
    __threadfence_block();
  }
  {
    f32x16 O[4];
    float ls;
    flash_map<64>(Qr + 64, K + 64, 512, Vt, Lkv, Lkv, 0.125f * LOG2E, O, ls, smem);
    const float il = lam / ls;
    float ss = 0.f;
#pragma unroll
    for (int et = 0; et < 4; ++et) {
#pragma unroll
      for (int q = 0; q < 4; ++q) {
        const float4 o = *(const float4*)(o0 + et * 16 + q * 4);
        const float ov[4] = {o.x, o.y, o.z, o.w};
#pragma unroll
        for (int e = 0; e < 4; ++e) { const float x = ov[e] - O[et][q * 4 + e] * il; O[et][q * 4 + e] = x; ss += x * x; }
      }
    }
    ss = wave_half_sum(ss);
    const float rstd = rsqrtf(ss * (1.f / 128.f) + EPS) * (1.f - li);
    const float* gn = p.in[I_DSUB] + l * 128;
#pragma unroll
    for (int et = 0; et < 4; ++et) {
      float v[16];
#pragma unroll
      for (int i = 0; i < 16; ++i) v[i] = O[et][i] * rstd * gn[et * 32 + (i & 3) + 8 * (i >> 2) + 4 * lh];
      store_sub_bf16(Qr + et * 32, v, lh);
    }
  }
}

DI void ret_out_item(const Params& p, int g, int l, int idx, char* smem) {
  const int tid = opaque_tid(), lane = tid & 63, wave = tid >> 6, lr = lane & 31, lh = lane >> 5;
  int head, c, L, nc, m0, b, ubase; bool ctx; size_t vb;
  if (idx < 512) { const int bl = idx >> 7; head = (idx >> 5) & 3; c = idx & 31; L = 4096; nc = 32; ctx = false; m0 = bl * 4096 + c * 128; b = g * 4 + bl; ubase = idx - c; vb = (size_t)bl * 512 * 4096; }
  else { const int r = idx - 512; const int bc = r >> 3; head = (r >> 1) & 3; c = r & 1; L = 256; nc = 2; ctx = true; m0 = TLG + bc * 256 + c * 128; b = bc; ubase = idx - c; vb = 4ull * 512 * 4096 + (size_t)bc * 512 * 256; }
  const float xf = p.in[I_RDEC][l * 8 + head], xb = p.in[I_RDEC][l * 8 + 4 + head];
  const float lgf = -log1pf(expf(-xf)) * LOG2E, lgb = -log1pf(expf(-xb)) * LOG2E;
  const float* U = (const float*)(p.ws + OFF_U) + (size_t)ubase * 2 * 8192;
  bf16_t* sRf = (bf16_t*)smem;
  bf16_t* sRb = sRf + 128 * 72;
  {
    const float* uc = U + (size_t)c * 2 * 8192;
#pragma unroll
    for (int i = 0; i < 8; ++i) {
      const int id = (tid + 256 * i) * 4, e = id >> 6, d = id & 63;
      const float4 a = *(const float4*)(uc + id);
      const float4 bq = *(const float4*)(uc + 8192 + id);
      uint2 ua, ub; ua.x = pk2(a.x, a.y); ua.y = pk2(a.z, a.w); ub.x = pk2(bq.x, bq.y); ub.y = pk2(bq.z, bq.w);
      *(uint2*)(sRf + e * 72 + d) = ua;
      *(uint2*)(sRb + e * 72 + d) = ub;
    }
  }
  __syncthreads();
  const int iq = wave * 32 + lr;
  const int m = m0 + iq;
  const bf16_t* Qp = (const bf16_t*)(p.ws + OFF_RQ) + (size_t)m * 256 + head * 64;
  bf16x8 q[4];
#pragma unroll
  for (int ks = 0; ks < 4; ++ks) q[ks] = *(const bf16x8*)(Qp + ks * 16 + lh * 8);
  f32x16 O[4];
  {
    const float qdf = exp2f(lgf * (float)(iq + 1)), qdb = exp2f(lgb * (float)(128 - iq));
#pragma unroll
    for (int et = 0; et < 4; ++et) {
      f32x16 xf_, xb_;
#pragma unroll
      for (int i = 0; i < 16; ++i) { xf_[i] = 0.f; xb_[i] = 0.f; }
#pragma unroll
      for (int ks = 0; ks < 4; ++ks) {
        const bf16x8 a = *(const bf16x8*)(sRf + (et * 32 + lr) * 72 + ks * 16 + lh * 8);
        const bf16x8 a2 = *(const bf16x8*)(sRb + (et * 32 + lr) * 72 + ks * 16 + lh * 8);
        xf_ = MFMA(a, q[ks], xf_);
        xb_ = MFMA(a2, q[ks], xb_);
      }
#pragma unroll
      for (int i = 0; i < 16; ++i) O[et][i] = qdf * xf_[i] + qdb * xb_[i];
    }
  }
  __syncthreads();
  bf16_t* sK = (bf16_t*)smem;
  bf16_t* sV = sK + 128 * 72;
  {
    const bf16_t* Kp = (const bf16_t*)(p.ws + OFF_RK) + (size_t)m0 * 256 + head * 64;
    const bf16_t* Vt = (const bf16_t*)(p.ws + OFF_RVT) + vb + (size_t)(head * 128) * L + c * 128;
#pragma unroll
    for (int i = 0; i < 4; ++i) { const int ci = tid + 256 * i; *(uint4*)(sK + (ci >> 3) * 72 + (ci & 7) * 8) = *(const uint4*)(Kp + (size_t)(ci >> 3) * 256 + (ci & 7) * 8); }
#pragma unroll
    for (int i = 0; i < 8; ++i) { const int ci = tid + 256 * i; *(uint4*)(sV + (ci >> 4) * 136 + (ci & 15) * 8) = *(const uint4*)(Vt + (size_t)(ci >> 4) * L + (ci & 15) * 8); }
  }
  __syncthreads();
  const int prow = perm23(lr);
#pragma unroll 1
  for (int kt = 0; kt < 4; ++kt) {
    f32x16 S;
#pragma unroll
    for (int i = 0; i < 16; ++i) S[i] = 0.f;
#pragma unroll
    for (int ks = 0; ks < 4; ++ks) {
      const bf16x8 a = *(const bf16x8*)(sK + (kt * 32 + prow) * 72 + ks * 16 + lh * 8);
      S = MFMA(a, q[ks], S);
    }
#pragma unroll
    for (int i = 0; i < 16; ++i) {
      const int j = kt * 32 + 16 * (i >> 3) + 8 * lh + (i & 7);
      const int dl = iq - j;
      S[i] *= (dl >= 0) ? exp2f(lgf * (float)dl) : exp2f(lgb * (float)(-dl));
    }
#pragma unroll
    for (int s = 0; s < 2; ++s) {
      uint4 u;
      u.x = pk2(S[8 * s + 0], S[8 * s + 1]); u.y = pk2(S[8 * s + 2], S[8 * s + 3]);
      u.z = pk2(S[8 * s + 4], S[8 * s + 5]); u.w = pk2(S[8 * s + 6], S[8 * s + 7]);
      const bf16x8 pf = __builtin_bit_cast(bf16x8, u);
#pragma unroll
      for (int et = 0; et < 4; ++et) {
        const bf16x8 a = *(const bf16x8*)(sV + (et * 32 + lr) * 136 + kt * 32 + s * 16 + lh * 8);
        O[et] = MFMA(a, pf, O[et]);
      }
    }
  }
  float ss = 0.f;
#pragma unroll
  for (int et = 0; et < 4; ++et)
#pragma unroll
    for (int i = 0; i < 16; ++i) ss += O[et][i] * O[et][i];
  ss = wave_half_sum(ss);
  const float rstd = rsqrtf(ss * (1.f / 128.f) + EPS);
  const float* gn = p.in[I_RGN] + l * 128;
  const bf16_t* rg = (const bf16_t*)(p.ws + OFF_RG) + (size_t)m * 512 + head * 128;
  bf16_t* d = (bf16_t*)(p.ws + OFF_ORR) + (size_t)m * LDO + head * 128;
#pragma unroll
  for (int et = 0; et < 4; ++et) {
    float v[16];
#pragma unroll
    for (int q4 = 0; q4 < 4; ++q4) {
      const uint2 u = *(const uint2*)(rg + et * 32 + q4 * 8 + lh * 4);
      const float gg[4] = {bflo(u.x), bfhi(u.x), bflo(u.y), bfhi(u.y)};
#pragma unroll
      for (int e = 0; e < 4; ++e) {
        const int i = q4 * 4 + e;
        const float sg = gg[e] / (1.f + expf(-gg[e]));
        v[i] = O[et][i] * rstd * gn[et * 32 + q4 * 8 + lh * 4 + e] * sg;
      }
    }
    store_sub_bf16(d + et * 32, v, lh);
  }
  __syncthreads();
}

DI void p4_phase(const Params& p, int g, int l, char* smem, int* s_item) {
  int* ctr = (int*)(p.ws + OFF_CTR) + (g * 2 + l);
  const int n_lat = 512;
  const int n_ret = g == 0 ? 640 : 512;
  const int n_cx = g == 0 ? 128 : 0;
  const int n_w = (g == 0 && l == 0) ? W_TILES : 0;
  const int total = 2 * n_lat + n_ret + 2 * n_cx + n_w;
  while (true) {
    if (threadIdx.x == 0) *s_item = atomicAdd(ctr, 1);
    __syncthreads();
    int t = *s_item;
    __syncthreads();
    if (t >= total) break;
    if (t < n_lat) attn_mla_item(p, l, false, t >> 7, (t >> 5) & 3, t & 31, smem);
    else if ((t -= n_lat) < n_lat) attn_diff_item(p, l, false, t >> 7, (t >> 5) & 3, t & 31, smem);
    else if ((t -= n_lat) < n_ret) ret_out_item(p, g, l, t, smem);
    else if ((t -= n_ret) < n_cx) attn_mla_item(p, l, true, t >> 3, (t >> 1) & 3, t & 1, smem);
    else if ((t -= n_cx) < n_cx) attn_diff_item(p, l, true, t >> 3, (t >> 1) & 3, t & 1, smem);
    else { t -= n_cx; weight_tile(p, 1, t, smem); }
  }
}

template <int FT>
DI void p5_tile(const Params& p, int l, int mt, int nt, char* smem) {
  const bf16_t* H = (const bf16_t*)(p.ws + OFF_H);
  const bf16_t* Wl = (const bf16_t*)(p.ws + OFF_W) + (size_t)l * W_LAYER;
  bf16_t* MG = (bf16_t*)(p.ws + OFF_MERGED);
  const int tid = opaque_tid(), lane = tid & 63, wave = tid >> 6, wt = wave >> 1, wf = wave & 1, lr = lane & 31, lh = lane >> 5;
  const int m0 = mt * 128, n0 = nt * (64 * FT);
  unsigned mgp[2][FT][8];
#pragma unroll
  for (int a = 0; a < 2; ++a)
#pragma unroll
    for (int b = 0; b < FT; ++b)
#pragma unroll
      for (int i = 0; i < 8; ++i) mgp[a][b][i] = 0u;
#pragma unroll 1
  for (int br = 0; br < 3; ++br) {
    unsigned sg[2][FT][8];
    {
      f32x16 ag[2][FT];
      zero_acc<2, FT>(ag);
      gemm_mainloop<2, 2, 2, FT, 64, 1>(H + (size_t)m0 * LDH, LDH, Wl + WO_IN + (size_t)(NZ + br * 1024 + n0) * LW1, LW1, 1024, ag, smem);
#pragma unroll
      for (int a = 0; a < 2; ++a)
#pragma unroll
        for (int b = 0; b < FT; ++b)
#pragma unroll
          for (int i = 0; i < 8; ++i)
            sg[a][b][i] = pk2(1.f / (1.f + __expf(-ag[a][b][2 * i])), 1.f / (1.f + __expf(-ag[a][b][2 * i + 1])));
    }
    f32x16 ao[2][FT];
    zero_acc<2, FT>(ao);
    const bf16_t* Ob = (const bf16_t*)(p.ws + (br == 0 ? OFF_DQ : (br == 1 ? OFF_ORR : OFF_OM)));
    gemm_mainloop<2, 2, 2, FT, 64, 1>(Ob + (size_t)m0 * LDO, LDO, Wl + WO_BR + (size_t)br * 1024 * LWBR + (size_t)n0 * LWBR, LWBR, 512, ao, smem);
#pragma unroll
    for (int a = 0; a < 2; ++a)
#pragma unroll
      for (int b = 0; b < FT; ++b)
#pragma unroll
        for (int i = 0; i < 8; ++i)
          mgp[a][b][i] = pk2(bflo(mgp[a][b][i]) + bflo(sg[a][b][i]) * ao[a][b][2 * i], bfhi(mgp[a][b][i]) + bfhi(sg[a][b][i]) * ao[a][b][2 * i + 1]);
  }
#pragma unroll
  for (int tt = 0; tt < 2; ++tt) {
    const int m = m0 + wt * 64 + tt * 32 + lr;
#pragma unroll
    for (int ft = 0; ft < FT; ++ft) {
      bf16_t* d = MG + (size_t)m * LDM + n0 + wf * (32 * FT) + ft * 32;
#pragma unroll
      for (int q = 0; q < 4; ++q) { uint2 u; u.x = mgp[tt][ft][q * 2]; u.y = mgp[tt][ft][q * 2 + 1]; *(uint2*)(d + q * 8 + lh * 4) = u; }
    }
  }
}

DI void p5_phase(const Params& p, int g, int l, char* smem) {
  for (int it = 0;; ++it) {
    int mt, nt;
    if (!tile_map<8>(it, 128, mt, nt)) break;
    p5_tile<2>(p, l, mt, nt, smem);
  }
  if (g == 0) {
    for (int it = 0;; ++it) {
      int mt, nt;
      if (!tile_map<16>(it, 32, mt, nt)) break;
      p5_tile<1>(p, l, 128 + mt, nt, smem);
    }
  }
}

template <int FT>
DI void resid_tile(const Params& p, int g, int l, int mode, int mt, int nt, char* smem) {
  const float* xin_p = p.in[I_XP]; const float* xin_s = p.in[I_XS];
  asm volatile("" : "+s"(xin_p), "+s"(xin_s));
  const int tid = opaque_tid(), lane = tid & 63, wave = tid >> 6, wt = wave >> 1, wf = wave & 1, lr = lane & 31, lh = lane >> 5;
  const bf16_t* Wl = (const bf16_t*)(p.ws + OFF_W) + (size_t)l * W_LAYER;
  const bf16_t* A = (const bf16_t*)(p.ws + (mode == 0 ? OFF_MERGED : OFF_UMLP));
  const int K = mode == 0 ? 1024 : 4096;
  const int lda = mode == 0 ? LDM : LDU, ldb = mode == 0 ? LW1 : LWDN;
  const bf16_t* B = Wl + (mode == 0 ? WO_OUT : WO_DN);
  const float* mod = (const float*)(p.ws + OFF_MOD);
  const int m0 = mt * 128, n0 = nt * (64 * FT);
  f32x16 acc[2][FT];
  zero_acc<2, FT>(acc);
  gemm_mainloop<2, 2, 2, FT, (FT == 4 ? 32 : 64), 1>(A + (size_t)m0 * lda, lda, B + (size_t)n0 * ldb, ldb, K, acc, smem);
#pragma unroll
  for (int tt = 0; tt < 2; ++tt) {
    const int m = m0 + wt * 64 + tt * 32 + lr;
    const Tok t = tokinfo(g, m);
    const float* gate = mod + (size_t)(l * 9 + t.cond) * 6144 + (mode == 0 ? 2048 : 5120);
    float* y = p.out + (t.ctx ? O_YP : O_YS) + t.xrow * 1024;
    const float* x = (mode == 0 && l == 0) ? ((t.ctx ? xin_p : xin_s) + t.xrow * 1024) : y;
#pragma unroll
    for (int ft = 0; ft < FT; ++ft)
#pragma unroll
      for (int q = 0; q < 4; ++q) {
        const int f = n0 + wf * (32 * FT) + ft * 32 + q * 8 + lh * 4;
        const float4 xv = *(const float4*)(x + f);
        const float4 gv = *(const float4*)(gate + f);
        float4 o;
        o.x = xv.x + gv.x * acc[tt][ft][q * 4 + 0]; o.y = xv.y + gv.y * acc[tt][ft][q * 4 + 1];
        o.z = xv.z + gv.z * acc[tt][ft][q * 4 + 2]; o.w = xv.w + gv.w * acc[tt][ft][q * 4 + 3];
        *(float4*)(y + f) = o;
      }
  }
}

DI void resid_gemm_phase(const Params& p, int g, int l, int mode, char* smem) {
  for (int it = 0;; ++it) {
    int mt, nt;
    if (!tile_map<4>(it, 128, mt, nt)) break;
    resid_tile<4>(p, g, l, mode, mt, nt, smem);
  }
  if (g == 0) {
    for (int it = 0;; ++it) {
      int mt, nt;
      if (!tile_map<8>(it, 32, mt, nt)) break;
      resid_tile<2>(p, g, l, mode, 128 + mt, nt, smem);
    }
  }
}

DI void up_phase(const Params& p, int g, int l, char* smem) {
  const int Tg = g == 0 ? TG : TLG;
  const int MT = Tg / 128;
  const bf16_t* H = (const bf16_t*)(p.ws + OFF_H);
  const bf16_t* B = (const bf16_t*)(p.ws + OFF_W) + (size_t)l * W_LAYER + WO_UP;
  bf16_t* Uo = (bf16_t*)(p.ws + OFF_UMLP);
  bf16_t* sT = (bf16_t*)smem;
  for (int it = 0;; ++it) {
    int mt, nt;
    if (!tile_map<16>(it, MT, mt, nt)) break;
    const int tid = opaque_tid(), lane = tid & 63, wave = tid >> 6, wt = wave >> 1, wf = wave & 1, lr = lane & 31, lh = lane >> 5;
    const int m0 = mt * 128, n0 = nt * 256;
    f32x16 acc[2][4];
    zero_acc<2, 4>(acc);
    gemm_mainloop<2, 2, 2, 4, 32, 1>(H + (size_t)m0 * LDH, LDH, B + (size_t)n0 * LW1, LW1, 1024, acc, smem);
#pragma unroll
    for (int tt = 0; tt < 2; ++tt) {
      const int r = wt * 64 + tt * 32 + lr;
#pragma unroll
      for (int ft = 0; ft < 4; ++ft) {
        float v[16];
#pragma unroll
        for (int i = 0; i < 16; ++i) { const float x = fmaxf(acc[tt][ft][i], 0.f); v[i] = x * x; }
        store_sub_bf16(sT + r * 264 + wf * 128 + ft * 32, v, lh);
      }
    }
    __syncthreads();
#pragma unroll
    for (int i = 0; i < 16; ++i) {
      const int ci = tid + 256 * i, r = ci >> 5, c = (ci & 31) * 8;
      *(uint4*)(Uo + (size_t)(m0 + r) * LDU + n0 + c) = *(const uint4*)(sT + r * 264 + c);
    }
    __syncthreads();
  }
}

__global__ void __launch_bounds__(256, 2) fwd_megakernel(Params p) {
  cg::grid_group grid = cg::this_grid();
  __shared__ __attribute__((aligned(16))) char smem[73728];
  __shared__ int s_item;
  __shared__ uint4 xb_words;
  if (threadIdx.x == 0) xb_words = make_uint4(0u, 0u, 0u, 0u);
  __syncthreads();
  const XcdBarrier xb = xcd_barrier_post((unsigned*)(p.ws + OFF_BAR), (volatile unsigned*)&xb_words);
  prep_phase(p, smem);
  if (p.ws == nullptr) grid.sync();
  xcd_barrier(xb);
#pragma unroll 1
  for (int g0 = 0; g0 < 2; ++g0) {
#pragma unroll 1
    for (int l0 = 0; l0 < 2; ++l0) {
#define PHASE_GL int g = g0, l = l0; asm volatile("" : "+s"(g), "+s"(l));
      { PHASE_GL rownorm_phase(p, g, l, 0); cache_convert(p, g, l, smem); }
      xcd_barrier(xb);
      { PHASE_GL gemm1_phase(p, g, l, smem); }
      xcd_barrier(xb);
      { PHASE_GL p3_phase(p, g, l, smem); }
      xcd_barrier(xb);
      { PHASE_GL ret_scan_phase(p, g, l); }
      xcd_barrier(xb);
      { PHASE_GL p4_phase(p, g, l, smem, &s_item); }
      xcd_barrier(xb);
      { PHASE_GL p5_phase(p, g, l, smem); }
      xcd_barrier(xb);
#if PROBE_P5
      { PHASE_GL p5_phase(p, g, l, smem); }
      xcd_barrier(xb);
#endif
#if PROBE_G1
      { PHASE_GL gemm1_phase(p, g, l, smem); }
      xcd_barrier(xb);
#endif
#if PROBE_SYNC2
      xcd_barrier(xb); xcd_barrier(xb); xcd_barrier(xb); xcd_barrier(xb); xcd_barrier(xb); xcd_barrier(xb); xcd_barrier(xb); xcd_barrier(xb); xcd_barrier(xb);
#endif
      { PHASE_GL resid_gemm_phase(p, g, l, 0, smem); }
      xcd_barrier(xb);
      { PHASE_GL rownorm_phase(p, g, l, 1); }
      xcd_barrier(xb);
      { PHASE_GL up_phase(p, g, l, smem); }
      xcd_barrier(xb);
#if PROBE_UP2
      { PHASE_GL up_phase(p, g, l, smem); }
      xcd_barrier(xb);
#endif
      { PHASE_GL resid_gemm_phase(p, g, l, 1, smem); }
      xcd_barrier(xb);
    }
  }
}

extern "C" void kernel_launch(void* const* d_in, const int* in_sizes, int n_in, void* d_out,
                              int out_size, void* d_ws, size_t ws_size, hipStream_t stream) {
  static int grid_blocks = 0;
  if (!grid_blocks) {
    int dev = 0, cus = 0, per_cu = 0;
    (void)hipGetDevice(&dev);
    (void)hipDeviceGetAttribute(&cus, hipDeviceAttributeMultiprocessorCount, dev);
    (void)hipOccupancyMaxActiveBlocksPerMultiprocessor(&per_cu, fwd_megakernel, 256, 0);
    if (per_cu > 2) per_cu = 2;
    if (per_cu < 1) per_cu = 1;
    grid_blocks = cus * per_cu;
    if (grid_blocks > 640) grid_blocks = 640;
  }
  Params p{};
  for (int i = 0; i < 30; ++i) p.in[i] = (const float*)d_in[i];
  p.out = (float*)d_out;
  p.ws = (char*)d_ws;
  (void)hipMemsetAsync((char*)d_ws + OFF_CTR, 0, OFF_SSQ - OFF_CTR, stream);
  void* args[] = {&p};
  hipError_t e = hipLaunchCooperativeKernel((void*)fwd_megakernel, dim3(grid_blocks), dim3(256), args, 0, stream);
  if (e != hipSuccess) fprintf(stderr, "cooperative launch failed: %s (grid %d)\n", hipGetErrorString(e), grid_blocks);
}
```

```cpp
#include <hip/hip_runtime.h>
#include <hip/hip_cooperative_groups.h>
#include <cstdio>
namespace cg = cooperative_groups;

typedef unsigned short bf16_t;
typedef __bf16 bf16x2_t __attribute__((ext_vector_type(2)));
typedef float f32x2_t __attribute__((ext_vector_type(2)));
using bf16x8 = __attribute__((ext_vector_type(8))) short;
using f32x16 = __attribute__((ext_vector_type(16))) float;
using u32x4 = __attribute__((ext_vector_type(4))) unsigned;
#define DI __device__ __forceinline__
#define MFMA(a, b, c) __builtin_amdgcn_mfma_f32_32x32x16_bf16((a), (b), (c), 0, 0, 0)

DI unsigned pk2(float a, float b) { f32x2_t v = {a, b}; return __builtin_bit_cast(unsigned, __builtin_convertvector(v, bf16x2_t)); }
DI bf16_t f2bf(float a) { return (bf16_t)(pk2(a, 0.f) & 0xffffu); }
DI float bflo(unsigned u) { return __uint_as_float(u << 16); }
DI float bfhi(unsigned u) { return __uint_as_float(u & 0xffff0000u); }

#ifndef PROBE_MLA2
#define PROBE_MLA2 0
#endif
#ifndef PROBE_P5
#define PROBE_P5 0
#endif
#ifndef PROBE_G1
#define PROBE_G1 0
#endif
#ifndef PROBE_UP2
#define PROBE_UP2 0
#endif
#ifndef PROBE_SYNC2
#define PROBE_SYNC2 0
#endif
constexpr int NZ = 3776;
constexpr int TG = 20480;
constexpr int TLG = 16384;
constexpr int KVR = 22528;
constexpr float EPS = 1e-6f;
constexpr float LOG2E = 1.4426950408889634f;

constexpr int LDH = 1088, LDU = 4160, LDM = 1088, LDO = 576;
constexpr int LW1 = 1088, LWQB = 448, LWKVB = 320, LWBR = 576, LWDN = 4160;
constexpr size_t W_IN = 6848ull * LW1, W_QB = 768ull * LWQB, W_KVB = 1024ull * LWKVB, W_BR = 3ull * 1024 * LWBR,
                 W_OUT = 1024ull * LW1, W_UP = 4096ull * LW1, W_DN = 1024ull * LWDN;
constexpr size_t WO_IN = 0, WO_QB = WO_IN + W_IN, WO_KVB = WO_QB + W_QB, WO_BR = WO_KVB + W_KVB, WO_OUT = WO_BR + W_BR,
                 WO_UP = WO_OUT + W_OUT, WO_DN = WO_UP + W_UP, W_LAYER = WO_DN + W_DN;

constexpr size_t al(size_t x) { return (x + 255) & ~(size_t)255; }
constexpr size_t OFF_W = 0;
constexpr size_t OFF_MOD = al(OFF_W + 2 * W_LAYER * 2);
constexpr size_t OFF_ROPE = al(OFF_MOD + 2 * 9 * 6144 * 4);
constexpr size_t OFF_SCAL = al(OFF_ROPE + 2048 * 4);
constexpr size_t OFF_CTR = al(OFF_SCAL + 256);
constexpr size_t OFF_BAR = al(OFF_CTR + 256);
constexpr size_t OFF_SSQ = al(OFF_BAR + 3456 * 4);
constexpr size_t OFF_H = al(OFF_SSQ + (size_t)TG * 16 * 4);
constexpr size_t OFF_DQ = al(OFF_H + (size_t)TG * LDH * 2);
constexpr size_t OFF_RQ = al(OFF_DQ + (size_t)TG * LDO * 2);
constexpr size_t OFF_RK = al(OFF_RQ + (size_t)TG * 256 * 2);
constexpr size_t OFF_RKT = al(OFF_RK + (size_t)TG * 256 * 2);
constexpr size_t OFF_RVT = al(OFF_RKT + (size_t)TG * 256 * 2);
constexpr size_t OFF_RG = al(OFF_RVT + (size_t)TG * 512 * 2);
constexpr size_t OFF_MQ = al(OFF_RG + (size_t)TG * 512 * 2);
constexpr size_t OFF_OM = al(OFF_MQ + (size_t)TG * 768 * 2);
constexpr size_t OFF_ORR = al(OFF_OM + (size_t)TG * LDO * 2);
constexpr size_t OFF_MQA = al(OFF_ORR + (size_t)TG * LDO * 2);
constexpr size_t OFF_MKVA = al(OFF_MQA + (size_t)TG * 384 * 2);
constexpr size_t OFF_MKR = al(OFF_MKVA + (size_t)TG * 256 * 2);
constexpr size_t OFF_CKVA = al(OFF_MKR + (size_t)TG * 64 * 2);
constexpr size_t OFF_CKR = al(OFF_CKVA + 2048ull * 256 * 2);
constexpr size_t OFF_DK = al(OFF_CKR + 2048ull * 64 * 2);
constexpr size_t OFF_DVT = al(OFF_DK + (size_t)KVR * 512 * 2);
constexpr size_t OFF_MK = al(OFF_DVT + (size_t)KVR * 512 * 2);
constexpr size_t OFF_MVT = al(OFF_MK + (size_t)KVR * 768 * 2);
constexpr size_t OFF_U = al(OFF_MVT + (size_t)KVR * 512 * 2);
constexpr size_t OFF_O0 = al(OFF_U + 640ull * 2 * 8192 * 4);
constexpr size_t OFF_END = al(OFF_O0 + 640ull * 64 * 256 * 4);
constexpr size_t OFF_MERGED = OFF_DK;
constexpr size_t OFF_UMLP = OFF_DQ;
static_assert((size_t)TG * LDM * 2 <= OFF_MK - OFF_DK, "merged alias");
static_assert((size_t)TG * LDU * 2 <= OFF_DK - OFF_DQ, "umlp alias");
static_assert(OFF_END <= 512ull * 1024 * 1024, "workspace");

constexpr size_t O_YP = 0, O_YS = 4194304, O_NDK = 37748736, O_NDV = 41943040, O_NCKV = 46137344, O_NKR = 48234496, O_NSR = 48758784;

struct Params {
  const float* in[30];
  float* out;
  char* ws;
};
enum { I_XP = 0, I_XS, I_CDK, I_CDV, I_CCKV, I_CKR, I_SR, I_C, I_CCTX, I_WMOD, I_BMOD, I_N1, I_N2, I_WIN, I_DQN, I_DKN, I_DLAM,
       I_DSUB, I_RDEC, I_RGN, I_QAN, I_WQB, I_KVAN, I_WKVB, I_MQN, I_MKN, I_WBR, I_WOUT, I_WUP, I_WDN };

struct Tok { int ctx, b, n, cond, bl, kvrow; size_t xrow; };
DI Tok tokinfo(int g, int m) {
  Tok t;
  if (m < TLG) { int tl = g * TLG + m; t.ctx = 0; t.b = tl >> 12; t.n = tl & 4095; t.cond = 1 + t.b; t.xrow = tl; t.bl = m >> 12; t.kvrow = t.bl * 4608 + t.n; }
  else { int tc = m - TLG; t.ctx = 1; t.b = tc >> 8; t.n = tc & 255; t.cond = 0; t.xrow = tc; t.bl = 0; t.kvrow = 18432 + tc; }
  return t;
}
DI size_t vt_base(const Tok& t) { return t.ctx ? (4ull * 512 * 4608 + (size_t)t.b * 512 * 256) : ((size_t)t.bl * 512 * 4608); }
DI int vt_L(const Tok& t) { return t.ctx ? 256 : 4608; }
DI size_t rvt_base(const Tok& t) { return t.ctx ? (4ull * 512 * 4096 + (size_t)t.b * 512 * 256) : ((size_t)t.bl * 512 * 4096); }
DI size_t rkt_base(const Tok& t) { return t.ctx ? (4ull * 256 * 4096 + (size_t)t.b * 256 * 256) : ((size_t)t.bl * 256 * 4096); }
DI int r_L(const Tok& t) { return t.ctx ? 256 : 4096; }

DI int opaque_tid() { int t = threadIdx.x; asm volatile("" : "+v"(t)); return t; }
DI int perm23(int r) { return (r & 0x13) | ((r & 4) << 1) | ((r & 8) >> 1); }
DI float wave_half_sum(float v) { return v + __shfl_xor(v, 32); }


#define XB_TMO      128
#define XB_XCNT(j)  (256  + 64 * (j))
#define XB_XSUB(j)  (1280 + 64 * (j))
#define XB_XGEN(j)  (2304 + 64 * (j))
#define XB_TOP      3328
#define XB_TOPGEN   3392
#define XCD_BAR_WORDS 3456
#define XB_SPIN_CAP (1u << 18)
DI unsigned xb_ld(unsigned* p) { return __hip_atomic_load(p, __ATOMIC_RELAXED, __HIP_MEMORY_SCOPE_AGENT); }
DI unsigned xb_add(unsigned* p, unsigned v) { return __hip_atomic_fetch_add(p, v, __ATOMIC_RELAXED, __HIP_MEMORY_SCOPE_AGENT); }
DI unsigned xb_xcc_id() { return (unsigned)__builtin_amdgcn_s_getreg((3 << 11) | 20) & 0xFu; }
#define XB_SPIN(cond, bar) do { unsigned _sp = 0; while (cond) { __builtin_amdgcn_s_sleep(1); \
    if ((++_sp & 255u) == 0u) { if (xb_ld(&(bar)[XB_TMO])) break; if (_sp > XB_SPIN_CAP) { atomicAdd(&(bar)[XB_TMO], 1u); break; } } } } while (0)
struct XcdBarrier { unsigned* bar; unsigned x; volatile unsigned* st; };
DI XcdBarrier xcd_barrier_post(unsigned* bar, volatile unsigned* st) {
  XcdBarrier b; b.bar = bar; b.x = xb_xcc_id(); b.st = st;
  if (threadIdx.x == 0) (void)xb_add(&bar[XB_XCNT(b.x)], 1u);
  return b;
}
DI void xcd_barrier_complete(unsigned* bar, unsigned x, unsigned& nloc, unsigned& nx) {
  const unsigned G = gridDim.x * gridDim.y * gridDim.z;
  unsigned sum, cnt, mine, sp = 0u;
  for (;;) {
    sum = 0u; cnt = 0u; mine = 0u;
#pragma unroll
    for (unsigned j = 0; j < 16; ++j) { const unsigned c = xb_ld(&bar[XB_XCNT(j)]); sum += c; cnt += (c > 0u) ? 1u : 0u; mine = (j == x) ? c : mine; }
    if (sum == G) break;
    __builtin_amdgcn_s_sleep(1);
    if ((++sp & 255u) == 0u) { if (xb_ld(&bar[XB_TMO])) break; if (sp > XB_SPIN_CAP) { atomicAdd(&bar[XB_TMO], 1u); break; } }
  }
  nloc = mine > 0u ? mine : 1u; nx = cnt > 0u ? cnt : 1u;
}
DI void xcd_barrier(const XcdBarrier& b) {
  asm volatile("s_waitcnt vmcnt(0)" ::: "memory");
  __syncthreads();
  if (threadIdx.x == 0) {
    unsigned* bar = b.bar;
    __builtin_amdgcn_s_waitcnt(0);
    unsigned nloc = b.st[0], nx = b.st[1];
    if (nloc == 0u) { xcd_barrier_complete(bar, b.x, nloc, nx); b.st[0] = nloc; b.st[1] = nx; }
    const unsigned old = xb_add(&bar[XB_XSUB(b.x)], 1u);
    const unsigned gen = old / nloc;
    if (old + 1u == (gen + 1u) * nloc) {
      __builtin_amdgcn_fence(__ATOMIC_RELEASE, "agent");
      asm volatile("s_waitcnt vmcnt(0)" ::: "memory");
      const unsigned og = xb_add(&bar[XB_TOP], 1u);
      const unsigned tg = og / nx;
      if (og + 1u == (tg + 1u) * nx) xb_add(&bar[XB_TOPGEN], 1u);
      else XB_SPIN(xb_ld(&bar[XB_TOPGEN]) == tg, bar);
      __builtin_amdgcn_fence(__ATOMIC_ACQUIRE, "agent");
      xb_add(&bar[XB_XGEN(b.x)], 1u);
      asm volatile("s_waitcnt vmcnt(0)" ::: "memory");
    } else {
      XB_SPIN(xb_ld(&bar[XB_XGEN(b.x)]) == gen, bar);
      __builtin_amdgcn_fence(__ATOMIC_ACQUIRE, "agent");
      asm volatile("s_waitcnt vmcnt(0)" ::: "memory");
    }
  }
  __syncthreads();
}

template <int BK> DI int lds_sw(int row) { return BK == 32 ? ((row >> 2) & 3) : ((row >> 1) & 7); }
template <int WT, int WF, int TT, int FT, int BK = 64, int D = 2>
DI void gemm_mainloop(const bf16_t* __restrict__ At, int lda, const bf16_t* __restrict__ Bf, int ldb, int K, f32x16 (&acc)[TT][FT], char* smem) {
  constexpr int BM = WT * TT * 32, BN = WF * FT * 32, LS = BK, CPR = BK / 8, RPP = 256 / CPR, NA = BM / RPP, NB = BN / RPP, STAGE = (BM + BN) * LS, KS = BK / 16;
  static_assert(2 * STAGE * 2 <= 73728, "LDS stages");
  static_assert(D == 1 || D == 2 || D == 4, "depth");
  const int tid = opaque_tid(), lane = tid & 63, wave = tid >> 6, wt = wave / WF, wf = wave % WF, lr = lane & 31, lh = lane >> 5;
  const int c8 = (tid % CPR) * 8, r0 = tid / CPR;
  const bf16_t* ap = At + (size_t)r0 * lda + c8;
  const bf16_t* bp = Bf + (size_t)r0 * ldb + c8;
  bf16_t* wA = (bf16_t*)smem + r0 * LS + (((tid % CPR) ^ lds_sw<BK>(r0)) * 8);
  bf16_t* wB = wA + BM * LS;
  int rof[KS];
#pragma unroll
  for (int ks = 0; ks < KS; ++ks) rof[ks] = ((ks * 2 + lh) ^ lds_sw<BK>(lr)) * 8;
  const bf16_t* rB = (const bf16_t*)smem + BM * LS + (wf * FT * 32 + lr) * LS;
  const bf16_t* rA = (const bf16_t*)smem + (wt * TT * 32 + lr) * LS;
  u32x4 ra[D][NA], rb[D][NB];
  const int nk = K / BK;
#pragma unroll
  for (int i = 0; i < NA; ++i) ra[0][i] = *(const u32x4*)(ap + (size_t)i * RPP * lda);
#pragma unroll
  for (int i = 0; i < NB; ++i) rb[0][i] = *(const u32x4*)(bp + (size_t)i * RPP * ldb);
#pragma unroll
  for (int i = 0; i < NA; ++i) *(u32x4*)(wA + RPP * i * LS) = ra[0][i];
#pragma unroll
  for (int i = 0; i < NB; ++i) *(u32x4*)(wB + RPP * i * LS) = rb[0][i];
#pragma unroll
  for (int d = 0; d < D; ++d) {
    if (1 + d < nk) {
      const int ko = (1 + d) * BK;
#pragma unroll
      for (int i = 0; i < NA; ++i) ra[d][i] = *(const u32x4*)(ap + (size_t)i * RPP * lda + ko);
#pragma unroll
      for (int i = 0; i < NB; ++i) rb[d][i] = *(const u32x4*)(bp + (size_t)i * RPP * ldb + ko);
    }
  }
  __syncthreads();
  for (int kb = 0; kb < nk; kb += D) {
#pragma unroll
    for (int j = 0; j < D; ++j) {
      const int kt = kb + j;
      const int so = (D == 1 ? (kt & 1) : (j & 1)) * STAGE;
#pragma unroll
      for (int ks = 0; ks < KS; ++ks) {
        bf16x8 fa[FT], tb[TT];
#pragma unroll
        for (int ft = 0; ft < FT; ++ft) fa[ft] = *(const bf16x8*)(rB + so + ft * 32 * LS + rof[ks]);
#pragma unroll
        for (int tt = 0; tt < TT; ++tt) tb[tt] = *(const bf16x8*)(rA + so + tt * 32 * LS + rof[ks]);
#pragma unroll
        for (int tt = 0; tt < TT; ++tt)
#pragma unroll
          for (int ft = 0; ft < FT; ++ft) acc[tt][ft] = MFMA(fa[ft], tb[tt], acc[tt][ft]);
      }
      if (kt + 1 < nk) {
        const int wo = STAGE - so;
#pragma unroll
        for (int i = 0; i < NA; ++i) *(u32x4*)(wA + wo + RPP * i * LS) = ra[j][i];
#pragma unroll
        for (int i = 0; i < NB; ++i) *(u32x4*)(wB + wo + RPP * i * LS) = rb[j][i];
        if (kt + 1 + D < nk) {
          const int ko = (kt + 1 + D) * BK;
#pragma unroll
          for (int i = 0; i < NA; ++i) ra[j][i] = *(const u32x4*)(ap + (size_t)i * RPP * lda + ko);
#pragma unroll
          for (int i = 0; i < NB; ++i) rb[j][i] = *(const u32x4*)(bp + (size_t)i * RPP * ldb + ko);
        }
      }
      __syncthreads();
    }
  }
}


template <int NT>
DI bool tile_map(int it, int MT, int& mt, int& nt) {
  const int G = gridDim.x, b = blockIdx.x;
  if ((G & 7) != 0) { const int t = b + it * G; mt = t / NT; nt = t % NT; return t < MT * NT; }
  const int x = b & 7, q = (b >> 3) + it * (G >> 3);
  const int bq = q / (NT * 4), rem = q % (NT * 4);
  const int band = x + 8 * bq;
  mt = band * 4 + (rem & 3); nt = rem >> 2;
  return band * 4 < MT;
}

template <int TT, int FT>
DI void zero_acc(f32x16 (&acc)[TT][FT]) {
#pragma unroll
  for (int a = 0; a < TT; ++a)
#pragma unroll
    for (int b = 0; b < FT; ++b)
#pragma unroll
      for (int i = 0; i < 16; ++i) acc[a][b][i] = 0.f;
}

DI void store_sub_bf16(bf16_t* dst, const float (&v)[16], int lh) {
#pragma unroll
  for (int q = 0; q < 4; ++q) {
    uint2 u; u.x = pk2(v[q * 4 + 0], v[q * 4 + 1]); u.y = pk2(v[q * 4 + 2], v[q * 4 + 3]);
    *(uint2*)(dst + q * 8 + lh * 4) = u;
  }
}
DI void store_sub_f32(float* dst, const float (&v)[16], int lh) {
#pragma unroll
  for (int q = 0; q < 4; ++q) *(float4*)(dst + q * 8 + lh * 4) = make_float4(v[q * 4 + 0], v[q * 4 + 1], v[q * 4 + 2], v[q * 4 + 3]);
}
DI void store_sub_T(bf16_t* dstT, size_t L, const float (&v)[16], int lh) {
#pragma unroll
  for (int i = 0; i < 16; ++i) dstT[(size_t)((i & 3) + 8 * (i >> 2) + 4 * lh) * L] = f2bf(v[i]);
}
DI void rope_sub(float (&v)[16], int pos, int lh, const float* tab) {
#pragma unroll
  for (int q = 0; q < 2; ++q) {
    const float4 c = *(const float4*)(tab + pos * 16 + q * 8 + lh * 4);
    const float4 s = *(const float4*)(tab + 1024 + pos * 16 + q * 8 + lh * 4);
    const float cc[4] = {c.x, c.y, c.z, c.w}, ss[4] = {s.x, s.y, s.z, s.w};
#pragma unroll
    for (int e = 0; e < 4; ++e) {
      const float x1 = v[q * 4 + e], x2 = v[q * 4 + e + 8];
      v[q * 4 + e] = x1 * cc[e] - x2 * ss[e];
      v[q * 4 + e + 8] = x2 * cc[e] + x1 * ss[e];
    }
  }
}

DI void transpose_tile(const float* __restrict__ src, bf16_t* __restrict__ dst, int K, int N, int tile, char* smem) {
  const int ldk = K + 64;
  float* s = (float*)smem;
  const int tid_ = opaque_tid();
  const int tn = N >> 6;
  const int k0 = (tile / tn) * 64, n0 = (tile % tn) * 64;
  for (int i = tid_; i < 4096; i += 256) { const int r = i >> 6, c = i & 63; s[r * 65 + c] = src[(size_t)(k0 + r) * N + n0 + c]; }
  __syncthreads();
  for (int i = tid_; i < 512; i += 256) {
    const int n = i >> 3, kc = (i & 7) * 8;
    uint4 v;
    v.x = pk2(s[(kc + 0) * 65 + n], s[(kc + 1) * 65 + n]);
    v.y = pk2(s[(kc + 2) * 65 + n], s[(kc + 3) * 65 + n]);
    v.z = pk2(s[(kc + 4) * 65 + n], s[(kc + 5) * 65 + n]);
    v.w = pk2(s[(kc + 6) * 65 + n], s[(kc + 7) * 65 + n]);
    *(uint4*)(dst + (size_t)(n0 + n) * ldk + k0 + kc) = v;
  }
  __syncthreads();
}

DI void mod_item(const Params& p, int item, char* smem) {
  const int tid = threadIdx.x, lane = tid & 63, wave = tid >> 6;
  const int l = item / 96, n0 = (item % 96) * 64;
  float* sv = (float*)smem;
  for (int i = tid; i < 9 * 1024; i += 256) {
    const int c = i >> 10, k = i & 1023;
    const float v = (c == 0) ? p.in[I_CCTX][k] : p.in[I_C][(c - 1) * 1024 + k];
    sv[i] = v / (1.f + expf(-v));
  }
  __syncthreads();
  float acc[9];
#pragma unroll
  for (int c = 0; c < 9; ++c) acc[c] = 0.f;
  const float* w = p.in[I_WMOD] + (size_t)l * 1024 * 6144 + n0 + lane;
  const int kb = wave * 256;
#pragma unroll 16
  for (int k = kb; k < kb + 256; ++k) {
    const float wv = w[(size_t)k * 6144];
#pragma unroll
    for (int c = 0; c < 9; ++c) acc[c] += sv[c * 1024 + k] * wv;
  }
  float* red = sv + 9 * 1024;
#pragma unroll
  for (int c = 0; c < 9; ++c) red[(wave * 9 + c) * 64 + lane] = acc[c];
  __syncthreads();
  float* mod = (float*)(p.ws + OFF_MOD);
  for (int i = tid; i < 9 * 64; i += 256) {
    const int c = i >> 6, n = i & 63;
    float s = red[(0 * 9 + c) * 64 + n] + red[(1 * 9 + c) * 64 + n] + red[(2 * 9 + c) * 64 + n] + red[(3 * 9 + c) * 64 + n];
    s += p.in[I_BMOD][l * 6144 + n0 + n];
    mod[(size_t)(l * 9 + c) * 6144 + n0 + n] = s;
  }
  __syncthreads();
}

constexpr int W_TILES = 1712 + 72 + 64 + 384 + 256 + 1024 + 1024;
DI void weight_tile(const Params& p, int l, int t, char* smem) {
  bf16_t* W = (bf16_t*)(p.ws + OFF_W);
  bf16_t* Wl = W + (size_t)l * W_LAYER;
  const float* src; bf16_t* dst; int K, N;
  if (t < 1712) { src = p.in[I_WIN] + (size_t)l * 6848 * 1024; dst = Wl + WO_IN; K = 1024; N = 6848; }
  else if ((t -= 1712) < 72) { src = p.in[I_WQB] + (size_t)l * 768 * 384; dst = Wl + WO_QB; K = 384; N = 768; }
  else if ((t -= 72) < 64) { src = p.in[I_WKVB] + (size_t)l * 1024 * 256; dst = Wl + WO_KVB; K = 256; N = 1024; }
  else if ((t -= 64) < 384) { const int i = t / 128; t -= i * 128; src = p.in[I_WBR] + (size_t)l * 3 * 512 * 1024 + (size_t)i * 512 * 1024; dst = Wl + WO_BR + (size_t)i * 1024 * LWBR; K = 512; N = 1024; }
  else if ((t -= 384) < 256) { src = p.in[I_WOUT] + (size_t)l * 1024 * 1024; dst = Wl + WO_OUT; K = 1024; N = 1024; }
  else if ((t -= 256) < 1024) { src = p.in[I_WUP] + (size_t)l * 1024 * 4096; dst = Wl + WO_UP; K = 1024; N = 4096; }
  else { t -= 1024; src = p.in[I_WDN] + (size_t)l * 4096 * 1024; dst = Wl + WO_DN; K = 4096; N = 1024; }
  transpose_tile(src, dst, K, N, t, smem);
}

DI void prep_phase(const Params& p, char* smem) {
  bf16_t* W = (bf16_t*)(p.ws + OFF_W);
  const int tid = threadIdx.x;
  constexpr int N_MOD = 192;
  constexpr int tiles_layer = 1712 + 72 + 64 + 384 + 256 + 1024 + 1024;
  const int total = 1 + N_MOD + tiles_layer;
  for (int item = blockIdx.x; item < total; item += gridDim.x) {
    if (item == 0) {
      float* tab = (float*)(p.ws + OFF_ROPE);
      for (int i = tid; i < 1024; i += 256) {
        const int pos = i >> 4, j = i & 15;
        const float inv = exp2f(-(float)j * (13.287712379549449f / 16.f));
        const float a = (float)pos * inv;
        tab[i] = cosf(a); tab[1024 + i] = sinf(a);
      }
      if (tid < 2) {
        const float* lm = p.in[I_DLAM] + tid * 256;
        float s1 = 0.f, s2 = 0.f;
        for (int k = 0; k < 64; ++k) { s1 += lm[k] * lm[64 + k]; s2 += lm[128 + k] * lm[192 + k]; }
        const float li = 0.8f - 0.6f * expf(-0.3f * (float)tid);
        ((float*)(p.ws + OFF_SCAL))[tid] = expf(s1) - expf(s2) + li;
      }
    } else if (item <= N_MOD) {
      mod_item(p, item - 1, smem);
    } else {
      weight_tile(p, 0, item - 1 - N_MOD, smem);
    }
  }
}

DI void rownorm_phase(const Params& p, int g, int l, int which) {
  const float* xin_p = p.in[I_XP]; const float* xin_s = p.in[I_XS];
  asm volatile("" : "+s"(xin_p), "+s"(xin_s));
  const int Tg = g == 0 ? TG : TLG;
  const int tid_ = opaque_tid();
  const int lane = tid_ & 63, wave = tid_ >> 6;
  const float* mod = (const float*)(p.ws + OFF_MOD);
  bf16_t* H = (bf16_t*)(p.ws + OFF_H);
  const float* gain = p.in[which ? I_N2 : I_N1] + l * 1024;
  for (int m = blockIdx.x * 4 + wave; m < Tg; m += gridDim.x * 4) {
    const Tok t = tokinfo(g, m);
    const float* xr;
    if (which == 0 && l == 0) xr = (t.ctx ? xin_p : xin_s) + t.xrow * 1024;
    else xr = p.out + (t.ctx ? O_YP : O_YS) + t.xrow * 1024;
    float4 v[4];
    float ss = 0.f;
#pragma unroll
    for (int i = 0; i < 4; ++i) { v[i] = ((const float4*)xr)[lane + 64 * i]; ss += v[i].x * v[i].x + v[i].y * v[i].y + v[i].z * v[i].z + v[i].w * v[i].w; }
#pragma unroll
    for (int o = 32; o >= 1; o >>= 1) ss += __shfl_xor(ss, o);
    const float rstd = rsqrtf(ss * (1.f / 1024.f) + EPS);
    const float* mrow = mod + (size_t)(l * 9 + t.cond) * 6144;
    const float* sh = mrow + (which ? 3072 : 0);
    const float* sc = mrow + (which ? 4096 : 1024);
#pragma unroll
    for (int i = 0; i < 4; ++i) {
      const int k = (lane + 64 * i) * 4;
      const float4 gg = *(const float4*)(gain + k), s4 = *(const float4*)(sc + k), h4 = *(const float4*)(sh + k);
      uint2 u;
      u.x = pk2(v[i].x * rstd * gg.x * (1.f + s4.x) + h4.x, v[i].y * rstd * gg.y * (1.f + s4.y) + h4.y);
      u.y = pk2(v[i].z * rstd * gg.z * (1.f + s4.z) + h4.z, v[i].w * rstd * gg.w * (1.f + s4.w) + h4.w);
      *(uint2*)(H + (size_t)m * LDH + k) = u;
    }
  }
}

DI void cache_convert(const Params& p, int g, int l, char* smem) {
  int nt = gridDim.x * 256; asm volatile("" : "+s"(nt));
  const int gt = blockIdx.x * 256 + opaque_tid();
  bf16_t* DK = (bf16_t*)(p.ws + OFF_DK);
  bf16_t* DVT = (bf16_t*)(p.ws + OFF_DVT);
  bf16_t* CKVA = (bf16_t*)(p.ws + OFF_CKVA);
  bf16_t* CKR = (bf16_t*)(p.ws + OFF_CKR);
  for (int i = gt; i < 4 * 512 * 128; i += nt) {
    const int c4 = (i & 127) * 4, pp = (i >> 7) & 511, bl = i >> 16;
    const float4 v = *(const float4*)(p.in[I_CDK] + ((size_t)((g * 4 + bl) * 2 + l) * 512 + pp) * 512 + c4);
    uint2 u; u.x = pk2(v.x, v.y); u.y = pk2(v.z, v.w);
    *(uint2*)(DK + (size_t)(bl * 4608 + 4096 + pp) * 512 + c4) = u;
  }
  {
    float* st = (float*)smem;
    const int tid = opaque_tid();
    for (int item = blockIdx.x; item < 4 * 8 * 8; item += gridDim.x) {
      const int bl = item >> 6, pt = (item >> 3) & 7, ct = item & 7;
      const float* src = p.in[I_CDV] + ((size_t)((g * 4 + bl) * 2 + l) * 512 + pt * 64) * 512 + ct * 64;
      for (int i = tid; i < 4096; i += 256) { const int r = i >> 6, c = i & 63; st[r * 65 + c] = src[(size_t)r * 512 + c]; }
      __syncthreads();
      for (int i = tid; i < 512; i += 256) {
        const int c = i >> 3, pc = (i & 7) * 8;
        uint4 v;
        v.x = pk2(st[(pc + 0) * 65 + c], st[(pc + 1) * 65 + c]); v.y = pk2(st[(pc + 2) * 65 + c], st[(pc + 3) * 65 + c]);
        v.z = pk2(st[(pc + 4) * 65 + c], st[(pc + 5) * 65 + c]); v.w = pk2(st[(pc + 6) * 65 + c], st[(pc + 7) * 65 + c]);
        *(uint4*)(DVT + (size_t)bl * 512 * 4608 + (size_t)(ct * 64 + c) * 4608 + 4096 + pt * 64 + pc) = v;
      }
      __syncthreads();
    }
  }
  for (int i = gt; i < 4 * 512 * 64; i += nt) {
    const int c4 = (i & 63) * 4, pp = (i >> 6) & 511, bl = i >> 15;
    const float4 v = *(const float4*)(p.in[I_CCKV] + ((size_t)((g * 4 + bl) * 2 + l) * 512 + pp) * 256 + c4);
    uint2 u; u.x = pk2(v.x, v.y); u.y = pk2(v.z, v.w);
    *(uint2*)(CKVA + (size_t)(bl * 512 + pp) * 256 + c4) = u;
  }
  for (int i = gt; i < 4 * 512 * 16; i += nt) {
    const int c4 = (i & 15) * 4, pp = (i >> 4) & 511, bl = i >> 13;
    const float4 v = *(const float4*)(p.in[I_CKR] + ((size_t)((g * 4 + bl) * 2 + l) * 512 + pp) * 64 + c4);
    uint2 u; u.x = pk2(v.x, v.y); u.y = pk2(v.z, v.w);
    *(uint2*)(CKR + (size_t)(bl * 512 + pp) * 64 + c4) = u;
  }
}

DI void gemm1_phase(const Params& p, int g, int l, char* smem) {
  const int Tg = g == 0 ? TG : TLG;
  const int MT = Tg / 128;
  constexpr int NT = 30;
  const bf16_t* H = (const bf16_t*)(p.ws + OFF_H);
  const bf16_t* WinT = (const bf16_t*)(p.ws + OFF_W) + (size_t)l * W_LAYER + WO_IN;
  const float* tab = (const float*)(p.ws + OFF_ROPE);
  float* SSQ = (float*)(p.ws + OFF_SSQ);
  for (int it = 0;; ++it) {
    int mt, nt;
    if (!tile_map<NT>(it, MT, mt, nt)) break;
    const int tid = opaque_tid(), lane = tid & 63, wave = tid >> 6, wt = wave >> 1, wf = wave & 1, lr = lane & 31, lh = lane >> 5;
    const int m0 = mt * 128, n0 = nt * 128;
    f32x16 acc[2][2];
    zero_acc<2, 2>(acc);
    gemm_mainloop<2, 2, 2, 2, 64, 1>(H + (size_t)m0 * LDH, LDH, WinT + (size_t)n0 * LW1, LW1, 1024, acc, smem);
    const int F = n0 + wf * 64;
    if (F >= NZ) continue;
#pragma unroll
    for (int tt = 0; tt < 2; ++tt) {
      const int m = m0 + wt * 64 + tt * 32 + lr;
      const Tok t = tokinfo(g, m);
      float v[2][16];
#pragma unroll
      for (int ft = 0; ft < 2; ++ft)
#pragma unroll
        for (int i = 0; i < 16; ++i) v[ft][i] = acc[tt][ft][i];
      if (F < 1024) {
        float ss = 0.f;
#pragma unroll
        for (int ft = 0; ft < 2; ++ft)
#pragma unroll
          for (int i = 0; i < 16; ++i) ss += v[ft][i] * v[ft][i];
        ss = wave_half_sum(ss);
        const float rstd = rsqrtf(ss * (1.f / 64.f) + EPS);
        const float* gn = p.in[F < 512 ? I_DQN : I_DKN] + l * 64;
#pragma unroll
        for (int ft = 0; ft < 2; ++ft)
#pragma unroll
          for (int i = 0; i < 16; ++i) v[ft][i] *= rstd * gn[ft * 32 + (i & 3) + 8 * (i >> 2) + 4 * lh];
        if (t.ctx) {
          if (F >= 512) {
            float* o = p.out + O_NDK + ((size_t)(t.b * 2 + l) * 256 + t.n) * 512 + (F - 512);
            store_sub_f32(o, v[0], lh); store_sub_f32(o + 32, v[1], lh);
          }
        } else {
          rope_sub(v[0], t.n >> 6, lh, tab); rope_sub(v[1], t.n & 63, lh, tab);
        }
        bf16_t* d = (F < 512) ? ((bf16_t*)(p.ws + OFF_DQ) + (size_t)m * LDO + F) : ((bf16_t*)(p.ws + OFF_DK) + (size_t)t.kvrow * 512 + (F - 512));
        store_sub_bf16(d, v[0], lh); store_sub_bf16(d + 32, v[1], lh);
      } else if (F < 1536) {
        const int c = F - 1024;
        if (t.ctx) {
          float* o = p.out + O_NDV + ((size_t)(t.b * 2 + l) * 256 + t.n) * 512 + c;
          store_sub_f32(o, v[0], lh); store_sub_f32(o + 32, v[1], lh);
        }
        const int L = vt_L(t);
        bf16_t* d = (bf16_t*)(p.ws + OFF_DVT) + vt_base(t) + (size_t)c * L + t.n;
        store_sub_T(d, L, v[0], lh); store_sub_T(d + (size_t)32 * L, L, v[1], lh);
      } else if (F < 2048) {
        const bool isk = F >= 1792;
        if (isk) {
#pragma unroll
          for (int ft = 0; ft < 2; ++ft)
#pragma unroll
            for (int i = 0; i < 16; ++i) v[ft][i] *= 0.125f;
        }
        if (!t.ctx) { rope_sub(v[0], t.n >> 6, lh, tab); rope_sub(v[1], t.n & 63, lh, tab); }
        if (!isk) {
          bf16_t* d = (bf16_t*)(p.ws + OFF_RQ) + (size_t)m * 256 + (F - 1536);
          store_sub_bf16(d, v[0], lh); store_sub_bf16(d + 32, v[1], lh);
        } else {
          bf16_t* d = (bf16_t*)(p.ws + OFF_RK) + (size_t)m * 256 + (F - 1792);
          store_sub_bf16(d, v[0], lh); store_sub_bf16(d + 32, v[1], lh);
          const int L = r_L(t);
          bf16_t* dT = (bf16_t*)(p.ws + OFF_RKT) + rkt_base(t) + (size_t)(F - 1792) * L + t.n;
          store_sub_T(dT, L, v[0], lh); store_sub_T(dT + (size_t)32 * L, L, v[1], lh);
        }
      } else if (F < 2560) {
        const int L = r_L(t);
        bf16_t* dT = (bf16_t*)(p.ws + OFF_RVT) + rvt_base(t) + (size_t)(F - 2048) * L + t.n;
        store_sub_T(dT, L, v[0], lh); store_sub_T(dT + (size_t)32 * L, L, v[1], lh);
      } else if (F < 3072) {
        bf16_t* d = (bf16_t*)(p.ws + OFF_RG) + (size_t)m * 512 + (F - 2560);
        store_sub_bf16(d, v[0], lh); store_sub_bf16(d + 32, v[1], lh);
      } else if (F < 3712) {
        const bool isq = F < 3456;
        float ss = 0.f;
#pragma unroll
        for (int ft = 0; ft < 2; ++ft)
#pragma unroll
          for (int i = 0; i < 16; ++i) ss += v[ft][i] * v[ft][i];
        ss = wave_half_sum(ss);
        const int c = isq ? (F - 3072) : (F - 3456);
        if (lh == 0) SSQ[(size_t)m * 16 + (isq ? 0 : 6) + (c >> 6)] = ss;
        const float* gn = p.in[isq ? I_QAN : I_KVAN] + l * (isq ? 384 : 256) + c;
#pragma unroll
        for (int ft = 0; ft < 2; ++ft)
#pragma unroll
          for (int i = 0; i < 16; ++i) v[ft][i] *= gn[ft * 32 + (i & 3) + 8 * (i >> 2) + 4 * lh];
        bf16_t* d = isq ? ((bf16_t*)(p.ws + OFF_MQA) + (size_t)m * 384 + c) : ((bf16_t*)(p.ws + OFF_MKVA) + (size_t)m * 256 + c);
        store_sub_bf16(d, v[0], lh); store_sub_bf16(d + 32, v[1], lh);
      } else {
        if (t.ctx) {
          float* o = p.out + O_NKR + ((size_t)(t.b * 2 + l) * 256 + t.n) * 64;
          store_sub_f32(o, v[0], lh); store_sub_f32(o + 32, v[1], lh);
        }
        bf16_t* d = (bf16_t*)(p.ws + OFF_MKR) + (size_t)m * 64;
        store_sub_bf16(d, v[0], lh); store_sub_bf16(d + 32, v[1], lh);
      }
    }
  }
}

DI void mq_tile(const Params& p, int g, int l, int mt, int head, char* smem) {
  const int tid = opaque_tid(), lane = tid & 63, wave = tid >> 6, lr = lane & 31, lh = lane >> 5;
  const bf16_t* A = (const bf16_t*)(p.ws + OFF_MQA) + (size_t)mt * 128 * 384;
  const bf16_t* B = (const bf16_t*)(p.ws + OFF_W) + (size_t)l * W_LAYER + WO_QB + (size_t)head * 192 * LWQB;
  f32x16 acc[1][6];
  zero_acc<1, 6>(acc);
  gemm_mainloop<4, 1, 1, 6, 32, 1>(A, 384, B, LWQB, 384, acc, smem);
  const int m = mt * 128 + wave * 32 + lr;
  const Tok t = tokinfo(g, m);
  const float* SSQ = (const float*)(p.ws + OFF_SSQ) + (size_t)m * 16;
  const float rq = rsqrtf((SSQ[0] + SSQ[1] + SSQ[2] + SSQ[3] + SSQ[4] + SSQ[5]) * (1.f / 384.f) + EPS);
  float ss = 0.f;
#pragma unroll
  for (int ft = 0; ft < 6; ++ft)
#pragma unroll
    for (int i = 0; i < 16; ++i) { const float x = acc[0][ft][i] * rq; ss += x * x; }
  ss = wave_half_sum(ss);
  const float rh = rsqrtf(ss * (1.f / 192.f) + EPS) * rq;
  const float* gn = p.in[I_MQN] + l * 192;
  const float* tab = (const float*)(p.ws + OFF_ROPE);
  bf16_t* d = (bf16_t*)(p.ws + OFF_MQ) + (size_t)m * 768 + head * 192;
#pragma unroll
  for (int ft = 0; ft < 6; ++ft) {
    float v[16];
#pragma unroll
    for (int i = 0; i < 16; ++i) v[i] = acc[0][ft][i] * rh * gn[ft * 32 + (i & 3) + 8 * (i >> 2) + 4 * lh];
    if (ft >= 4 && !t.ctx) rope_sub(v, ft == 4 ? (t.n >> 6) : (t.n & 63), lh, tab);
    store_sub_bf16(d + ft * 32, v, lh);
  }
}

DI void mkv_tile(const Params& p, int g, int l, int mt, int j, bool cached, char* smem) {
  const int tid = opaque_tid(), lane = tid & 63, wave = tid >> 6, lr = lane & 31, lh = lane >> 5;
  const bf16_t* A = (const bf16_t*)(p.ws + (cached ? OFF_CKVA : OFF_MKVA)) + (size_t)mt * 128 * 256;
  const bf16_t* B = (const bf16_t*)(p.ws + OFF_W) + (size_t)l * W_LAYER + WO_KVB + (size_t)j * 128 * LWKVB;
  f32x16 acc[1][4];
  zero_acc<1, 4>(acc);
  gemm_mainloop<4, 1, 1, 4, 32, 1>(A, 256, B, LWKVB, 256, acc, smem);
  const int m = mt * 128 + wave * 32 + lr;
  const int head = j >> 1;
  int ctx = 0, kvrow, L, pos, n = 0, bb = 0;
  size_t vbase;
  float rkva = 1.f;
  if (cached) {
    const int bl = m >> 9, pp = m & 511;
    kvrow = bl * 4608 + 4096 + pp; L = 4608; pos = 4096 + pp; vbase = (size_t)bl * 512 * 4608;
  } else {
    const Tok t = tokinfo(g, m);
    ctx = t.ctx; kvrow = t.kvrow; L = vt_L(t); pos = t.n; n = t.n; bb = t.b; vbase = vt_base(t);
    const float* SSQ = (const float*)(p.ws + OFF_SSQ) + (size_t)m * 16;
    rkva = rsqrtf((SSQ[6] + SSQ[7] + SSQ[8] + SSQ[9]) * (1.f / 256.f) + EPS);
  }
  if ((j & 1) == 0) {
    const bf16_t* krp = (const bf16_t*)(p.ws + (cached ? OFF_CKR : OFF_MKR)) + (size_t)m * 64 + lh * 32;
    u32x4 krq[4];
#pragma unroll
    for (int q = 0; q < 4; ++q) krq[q] = *(const u32x4*)(krp + q * 8);
    float ss = 0.f;
#pragma unroll
    for (int ft = 0; ft < 4; ++ft)
#pragma unroll
      for (int i = 0; i < 16; ++i) { const float x = acc[0][ft][i] * rkva; ss += x * x; }
#pragma unroll
    for (int q = 0; q < 4; ++q)
#pragma unroll
      for (int e = 0; e < 4; ++e) { const float a = bflo(krq[q][e]), b = bfhi(krq[q][e]); ss += a * a + b * b; }
    ss = wave_half_sum(ss);
    const float rh = rsqrtf(ss * (1.f / 192.f) + EPS);
    const float* gn = p.in[I_MKN] + l * 192;
    bf16_t* d = (bf16_t*)(p.ws + OFF_MK) + (size_t)kvrow * 768 + head * 192;
#pragma unroll
    for (int ft = 0; ft < 4; ++ft) {
      float v[16];
#pragma unroll
      for (int i = 0; i < 16; ++i) v[i] = acc[0][ft][i] * rkva * rh * gn[ft * 32 + (i & 3) + 8 * (i >> 2) + 4 * lh];
      store_sub_bf16(d + ft * 32, v, lh);
    }
    {
      float kr[32];
#pragma unroll
      for (int q = 0; q < 4; ++q)
#pragma unroll
        for (int e = 0; e < 4; ++e) { kr[q * 8 + 2 * e] = bflo(krq[q][e]); kr[q * 8 + 2 * e + 1] = bfhi(krq[q][e]); }
#pragma unroll
      for (int q = 0; q < 32; ++q) kr[q] *= rh * gn[128 + lh * 32 + q];
      if (!cached && !ctx) {
        const float* tab = (const float*)(p.ws + OFF_ROPE);
        const int ps = lh == 0 ? (n >> 6) : (n & 63);
#pragma unroll
        for (int q = 0; q < 16; ++q) {
          const float c = tab[ps * 16 + q], sn = tab[1024 + ps * 16 + q];
          const float x1 = kr[q], x2 = kr[q + 16];
          kr[q] = x1 * c - x2 * sn; kr[q + 16] = x2 * c + x1 * sn;
        }
      }
#pragma unroll
      for (int q = 0; q < 4; ++q) {
        uint4 u;
        u.x = pk2(kr[q * 8 + 0], kr[q * 8 + 1]); u.y = pk2(kr[q * 8 + 2], kr[q * 8 + 3]);
        u.z = pk2(kr[q * 8 + 4], kr[q * 8 + 5]); u.w = pk2(kr[q * 8 + 6], kr[q * 8 + 7]);
        *(uint4*)(d + 128 + lh * 32 + q * 8) = u;
      }
    }
    if (ctx && j == 0) {
      const bf16_t* src = (const bf16_t*)(p.ws + OFF_MKVA) + (size_t)m * 256 + lh * 128;
      float* o = p.out + O_NCKV + ((size_t)(bb * 2 + l) * 256 + n) * 256 + lh * 128;
#pragma unroll 4
      for (int q = 0; q < 16; ++q) {
        const uint4 u = *(const uint4*)(src + q * 8);
        *(float4*)(o + q * 8) = make_float4(bflo(u.x) * rkva, bfhi(u.x) * rkva, bflo(u.y) * rkva, bfhi(u.y) * rkva);
        *(float4*)(o + q * 8 + 4) = make_float4(bflo(u.z) * rkva, bfhi(u.z) * rkva, bflo(u.w) * rkva, bfhi(u.w) * rkva);
      }
    }
  } else {
    bf16_t* dT = (bf16_t*)(p.ws + OFF_MVT) + vbase + (size_t)(head * 128) * L + pos;
#pragma unroll
    for (int ft = 0; ft < 4; ++ft) {
      float v[16];
#pragma unroll
      for (int i = 0; i < 16; ++i) v[i] = acc[0][ft][i] * rkva;
      store_sub_T(dT + (size_t)(ft * 32) * L, L, v, lh);
    }
  }
}

DI void retU_item(const Params& p, int l, int idx, char* smem) {
  const int tid = opaque_tid(), lane = tid & 63, wave = tid >> 6, lr = lane & 31, lh = lane >> 5;
  int head, c, L; size_t kb, vb;
  if (idx < 512) { const int bl = idx >> 7; head = (idx >> 5) & 3; c = idx & 31; L = 4096; kb = (size_t)bl * 256 * 4096; vb = (size_t)bl * 512 * 4096; }
  else { const int r = idx - 512; const int bc = r >> 3; head = (r >> 1) & 3; c = r & 1; L = 256; kb = 4ull * 256 * 4096 + (size_t)bc * 256 * 256; vb = 4ull * 512 * 4096 + (size_t)bc * 512 * 256; }
  const bf16_t* Kt = (const bf16_t*)(p.ws + OFF_RKT) + kb + (size_t)(head * 64) * L + c * 128;
  const bf16_t* Vt = (const bf16_t*)(p.ws + OFF_RVT) + vb + (size_t)(head * 128) * L + c * 128;
  const float xf = p.in[I_RDEC][l * 8 + head], xb = p.in[I_RDEC][l * 8 + 4 + head];
  const float lgf = -log1pf(expf(-xf)) * LOG2E, lgb = -log1pf(expf(-xb)) * LOG2E;
  bf16_t* sKf = (bf16_t*)smem;
  bf16_t* sKb = sKf + 64 * 136;
  bf16x8 vf[8];
#pragma unroll
  for (int ks = 0; ks < 8; ++ks) vf[ks] = *(const bf16x8*)(Vt + (size_t)(wave * 32 + lr) * L + ks * 16 + lh * 8);
  for (int i = tid; i < 1024; i += 256) {
    const int d = i >> 4, tc = (i & 15) * 8;
    const uint4 u = *(const uint4*)(Kt + (size_t)d * L + tc);
    const float x[8] = {bflo(u.x), bfhi(u.x), bflo(u.y), bfhi(u.y), bflo(u.z), bfhi(u.z), bflo(u.w), bfhi(u.w)};
    float wf_[8], wb_[8];
#pragma unroll
    for (int e = 0; e < 8; ++e) { wf_[e] = exp2f(lgf * (float)(127 - tc - e)); wb_[e] = exp2f(lgb * (float)(tc + e)); }
    uint4 a, b;
    a.x = pk2(x[0] * wf_[0], x[1] * wf_[1]); a.y = pk2(x[2] * wf_[2], x[3] * wf_[3]); a.z = pk2(x[4] * wf_[4], x[5] * wf_[5]); a.w = pk2(x[6] * wf_[6], x[7] * wf_[7]);
    b.x = pk2(x[0] * wb_[0], x[1] * wb_[1]); b.y = pk2(x[2] * wb_[2], x[3] * wb_[3]); b.z = pk2(x[4] * wb_[4], x[5] * wb_[5]); b.w = pk2(x[6] * wb_[6], x[7] * wb_[7]);
    *(uint4*)(sKf + d * 136 + tc) = a;
    *(uint4*)(sKb + d * 136 + tc) = b;
  }
  __syncthreads();
  f32x16 af[2], ab[2];
#pragma unroll
  for (int s = 0; s < 2; ++s)
#pragma unroll
    for (int i = 0; i < 16; ++i) { af[s][i] = 0.f; ab[s][i] = 0.f; }
#pragma unroll
  for (int ks = 0; ks < 8; ++ks) {
#pragma unroll
    for (int ds = 0; ds < 2; ++ds) {
      const bf16x8 bF = *(const bf16x8*)(sKf + (ds * 32 + lr) * 136 + ks * 16 + lh * 8);
      const bf16x8 bB = *(const bf16x8*)(sKb + (ds * 32 + lr) * 136 + ks * 16 + lh * 8);
      af[ds] = MFMA(vf[ks], bF, af[ds]);
      ab[ds] = MFMA(vf[ks], bB, ab[ds]);
    }
  }
  float* U = (float*)(p.ws + OFF_U) + (size_t)idx * 2 * 8192;
#pragma unroll
  for (int ds = 0; ds < 2; ++ds)
#pragma unroll
    for (int i = 0; i < 16; ++i) {
      const int e = wave * 32 + (i & 3) + 8 * (i >> 2) + 4 * lh;
      U[e * 64 + ds * 32 + lr] = af[ds][i];
      U[8192 + e * 64 + ds * 32 + lr] = ab[ds][i];
    }
  __syncthreads();
}

DI void p3_phase(const Params& p, int g, int l, char* smem) {
  const int Tg = g == 0 ? TG : TLG;
  const int MT = Tg / 128;
  const int n_mq = MT * 4, n_mkv = MT * 8, n_c = 16 * 8, n_u = g == 0 ? 640 : 512;
  const int G = gridDim.x;
  int o1 = n_mq; while (o1 >= G) o1 -= G;
  int o2 = n_mq + n_mkv; while (o2 >= G) o2 -= G;
  int o3 = n_mq + n_mkv + n_c; while (o3 >= G) o3 -= G;
  int s1 = (int)blockIdx.x - o1; if (s1 < 0) s1 += G;
  int s2 = (int)blockIdx.x - o2; if (s2 < 0) s2 += G;
  int s3 = (int)blockIdx.x - o3; if (s3 < 0) s3 += G;
  for (int t = blockIdx.x; t < n_mq; t += G) mq_tile(p, g, l, t >> 2, t & 3, smem);
  for (int t = s1; t < n_mkv; t += G) mkv_tile(p, g, l, t >> 3, t & 7, false, smem);
  for (int t = s2; t < n_c; t += G) mkv_tile(p, g, l, t >> 3, t & 7, true, smem);
  for (int t = s3; t < n_u; t += G) retU_item(p, l, t, smem);
}

DI void ret_scan_phase(const Params& p, int g, int l) {
  int nthr = gridDim.x * 256; asm volatile("" : "+s"(nthr));
  const int gt = blockIdx.x * 256 + opaque_tid();
  const int nseq_lat = 16, nseq = g == 0 ? 16 + 64 : 16;
  float* Ub = (float*)(p.ws + OFF_U);
  for (int w = gt; w < nseq * 2 * 8192; w += nthr) {
    const int el = w & 8191, dir = (w >> 13) & 1, sq = w >> 14;
    const int e = el >> 6, d = el & 63;
    int head, nc, b, ubase; bool ctx;
    if (sq < nseq_lat) { const int bl = sq >> 2; head = sq & 3; nc = 32; ctx = false; b = g * 4 + bl; ubase = (bl * 4 + head) * 32; }
    else { const int r = sq - nseq_lat; const int bc = r >> 2; head = r & 3; nc = 2; ctx = true; b = bc; ubase = 512 + (bc * 4 + head) * 2; }
    const float x = p.in[I_RDEC][l * 8 + dir * 4 + head];
    const float wgt = exp2f(-log1pf(expf(-x)) * LOG2E * 128.f);
    float R = ctx ? 0.f : p.in[I_SR][((size_t)((b * 2 + l) * 2 + dir) * 4 + head) * 8192 + d * 128 + e];
    float* u = Ub + (size_t)ubase * 2 * 8192 + dir * 8192 + el;
    if (dir == 0) {
      for (int c = 0; c < nc; ++c) { float* q = u + (size_t)c * 2 * 8192; const float t = *q; *q = R; R = wgt * R + t; }
    } else {
      for (int c = nc - 1; c >= 0; --c) { float* q = u + (size_t)c * 2 * 8192; const float t = *q; *q = R; R = wgt * R + t; }
    }
    if (ctx) p.out[O_NSR + ((size_t)((b * 2 + l) * 2 + dir) * 4 + head) * 8192 + d * 128 + e] = R;
  }
}

template <int DQK>
DI void flash_map(const bf16_t* __restrict__ Qrow, const bf16_t* __restrict__ Kb, int ldk, const bf16_t* __restrict__ Vt, int Lkv, int nkeys, float sc,
                  f32x16 (&O)[4], float& lsum, char* smem) {
  constexpr int KS = DQK / 16, KSTR = DQK + 8, NK = DQK / 32;
  const int tid = opaque_tid(), lane = tid & 63, lr = lane & 31, lh = lane >> 5;
  bf16_t* sK = (bf16_t*)smem;
  bf16_t* sV = sK + 64 * KSTR;
  bf16x8 q[KS];
#pragma unroll
  for (int ks = 0; ks < KS; ++ks) q[ks] = *(const bf16x8*)(Qrow + ks * 16 + lh * 8);
#pragma unroll
  for (int et = 0; et < 4; ++et)
#pragma unroll
    for (int i = 0; i < 16; ++i) O[et][i] = 0.f;
  float mrun = -1e30f, lrun = 0.f;
  u32x4 rk[NK], rv[4];
  const bf16_t* kp = Kb + (size_t)(tid >> 2) * ldk + (tid & 3) * 8;
  const bf16_t* vp = Vt + (size_t)(tid >> 1) * Lkv + (tid & 1) * 32;
  bf16_t* skw = sK + (tid >> 2) * KSTR + (tid & 3) * 8;
  bf16_t* svw = sV + (tid >> 1) * 72 + (tid & 1) * 32;
#pragma unroll
  for (int i = 0; i < NK; ++i) rk[i] = *(const u32x4*)(kp + i * 32);
#pragma unroll
  for (int i = 0; i < 4; ++i) rv[i] = *(const u32x4*)(vp + i * 8);
  const int nt = nkeys >> 6;
  const int prow = perm23(lr);
  for (int kt = 0; kt < nt; ++kt) {
#pragma unroll
    for (int i = 0; i < NK; ++i) *(u32x4*)(skw + i * 32) = rk[i];
#pragma unroll
    for (int i = 0; i < 4; ++i) *(u32x4*)(svw + i * 8) = rv[i];
    __syncthreads();
    if (kt + 1 < nt) {
      kp += (size_t)64 * ldk;
      vp += 64;
#pragma unroll
      for (int i = 0; i < NK; ++i) rk[i] = *(const u32x4*)(kp + i * 32);
#pragma unroll
      for (int i = 0; i < 4; ++i) rv[i] = *(const u32x4*)(vp + i * 8);
    }

    f32x16 S[2];
#pragma unroll
    for (int sub = 0; sub < 2; ++sub) {
#pragma unroll
      for (int i = 0; i < 16; ++i) S[sub][i] = 0.f;
#pragma unroll
      for (int ks = 0; ks < KS; ++ks) {
        const bf16x8 a = *(const bf16x8*)(sK + (sub * 32 + prow) * KSTR + ks * 16 + lh * 8);
        S[sub] = MFMA(a, q[ks], S[sub]);
      }

    }
    float mx = S[0][0];
#pragma unroll
    for (int i = 1; i < 16; ++i) mx = fmaxf(mx, S[0][i]);
#pragma unroll
    for (int i = 0; i < 16; ++i) mx = fmaxf(mx, S[1][i]);
    mx = fmaxf(mx, __shfl_xor(mx, 32));
    const float mnew = fmaxf(mrun, mx * sc);
    const bool moved = __builtin_amdgcn_ballot_w64(mnew > mrun) != 0ull;
    float ps = 0.f;
#pragma unroll
    for (int sub = 0; sub < 2; ++sub)
#pragma unroll
      for (int i = 0; i < 16; ++i) { const float e = __builtin_amdgcn_exp2f(S[sub][i] * sc - mnew); S[sub][i] = e; ps += e; }
    if (moved) {
      const float alpha = __builtin_amdgcn_exp2f(mrun - mnew);
      lrun *= alpha;
#pragma unroll
      for (int et = 0; et < 4; ++et)
#pragma unroll
        for (int i = 0; i < 16; ++i) O[et][i] *= alpha;
    }
    mrun = mnew;
    lrun += ps;

#pragma unroll
    for (int sub = 0; sub < 2; ++sub)
#pragma unroll
      for (int s = 0; s < 2; ++s) {
        uint4 u;
        u.x = pk2(S[sub][8 * s + 0], S[sub][8 * s + 1]); u.y = pk2(S[sub][8 * s + 2], S[sub][8 * s + 3]);
        u.z = pk2(S[sub][8 * s + 4], S[sub][8 * s + 5]); u.w = pk2(S[sub][8 * s + 6], S[sub][8 * s + 7]);
        const bf16x8 pf = __builtin_bit_cast(bf16x8, u);
#pragma unroll
        for (int et = 0; et < 4; ++et) {
          const bf16x8 a = *(const bf16x8*)(sV + (et * 32 + lr) * 72 + sub * 32 + s * 16 + lh * 8);
          O[et] = MFMA(a, pf, O[et]);
        }

      }
    __syncthreads();
  }
  lsum = wave_half_sum(lrun);
}

DI void attn_mla_item(const Params& p, int l, bool ctx, int bs, int head, int qt, char* smem) {
  const int tid = opaque_tid(), lane = tid & 63, wave = tid >> 6, lr = lane & 31, lh = lane >> 5;
  const int m = (ctx ? TLG + bs * 256 : bs * 4096) + qt * 128 + wave * 32 + lr;
  const int kv0 = ctx ? 18432 + bs * 256 : bs * 4608;
  const int Lkv = ctx ? 256 : 4608;
  const size_t vb = ctx ? (4ull * 512 * 4608 + (size_t)bs * 512 * 256) : ((size_t)bs * 512 * 4608);
  const bf16_t* Q = (const bf16_t*)(p.ws + OFF_MQ) + (size_t)m * 768 + head * 192;
  const bf16_t* K = (const bf16_t*)(p.ws + OFF_MK) + (size_t)kv0 * 768 + head * 192;
  const bf16_t* Vt = (const bf16_t*)(p.ws + OFF_MVT) + vb + (size_t)(head * 128) * Lkv;
  f32x16 O[4];
  float ls;
  flash_map<192>(Q, K, 768, Vt, Lkv, Lkv, 0.07216878364870322f * LOG2E, O, ls, smem);
  const float il = 1.f / ls;
  bf16_t* d = (bf16_t*)(p.ws + OFF_OM) + (size_t)m * LDO + head * 128;
#pragma unroll
  for (int et = 0; et < 4; ++et) {
    float v[16];
#pragma unroll
    for (int i = 0; i < 16; ++i) v[i] = O[et][i] * il;
    store_sub_bf16(d + et * 32, v, lh);
  }
}

DI void attn_diff_item(const Params& p, int l, bool ctx, int bs, int head, int qt, char* smem) {
  const int tid = opaque_tid(), lane = tid & 63, wave = tid >> 6, lr = lane & 31, lh = lane >> 5;
  const int m = (ctx ? TLG + bs * 256 : bs * 4096) + qt * 128 + wave * 32 + lr;
  const int kv0 = ctx ? 18432 + bs * 256 : bs * 4608;
  const int Lkv = ctx ? 256 : 4608;
  const size_t vb = ctx ? (4ull * 512 * 4608 + (size_t)bs * 512 * 256) : ((size_t)bs * 512 * 4608);
  bf16_t* Qr = (bf16_t*)(p.ws + OFF_DQ) + (size_t)m * LDO + head * 128;
  const bf16_t* K = (const bf16_t*)(p.ws + OFF_DK) + (size_t)kv0 * 512 + head * 128;
  const bf16_t* Vt = (const bf16_t*)(p.ws + OFF_DVT) + vb + (size_t)(head * 128) * Lkv;
  const float lam = ((const float*)(p.ws + OFF_SCAL))[l];
  const float li = 0.8f - 0.6f * expf(-0.3f * (float)l);
  float* o0 = (float*)(p.ws + OFF_O0) + ((size_t)blockIdx.x * 256 + tid) * 64;
  {
    f32x16 O[4];
    float ls;
    flash_map<64>(Qr, K, 512, Vt, Lkv, Lkv, 0.125f * LOG2E, O, ls, smem);
    const float il = 1.f / ls;
#pragma unroll
    for (int et = 0; et < 4; ++et)
#pragma unroll
      for (int q = 0; q < 4; ++q)
        *(float4*)(o0 + et * 16 + q * 4) = make_float4(O[et][q * 4] * il, O[et][q * 4 + 1] * il, O[et][q * 4 + 2] * il, O[et][q * 4 + 3] * il);
    __threadfence_block();
  }
  {
    f32x16 O[4];
    float ls;
    flash_map<64>(Qr + 64, K + 64, 512, Vt, Lkv, Lkv, 0.125f * LOG2E, O, ls, smem);
    const float il = lam / ls;
    float ss = 0.f;
#pragma unroll
    for (int et = 0; et < 4; ++et) {
#pragma unroll
      for (int q = 0; q < 4; ++q) {
        const float4 o = *(const float4*)(o0 + et * 16 + q * 4);
        const float ov[4] = {o.x, o.y, o.z, o.w};
#pragma unroll
        for (int e = 0; e < 4; ++e) { const float x = ov[e] - O[et][q * 4 + e] * il; O[et][q * 4 + e] = x; ss += x * x; }
      }
    }
    ss = wave_half_sum(ss);
    const float rstd = rsqrtf(ss * (1.f / 128.f) + EPS) * (1.f - li);
    const float* gn = p.in[I_DSUB] + l * 128;
#pragma unroll
    for (int et = 0; et < 4; ++et) {
      float v[16];
#pragma unroll
      for (int i = 0; i < 16; ++i) v[i] = O[et][i] * rstd * gn[et * 32 + (i & 3) + 8 * (i >> 2) + 4 * lh];
      store_sub_bf16(Qr + et * 32, v, lh);
    }
  }
}

DI void ret_out_item(const Params& p, int g, int l, int idx, char* smem) {
  const int tid = opaque_tid(), lane = tid & 63, wave = tid >> 6, lr = lane & 31, lh = lane >> 5;
  int head, c, L, nc, m0, b, ubase; bool ctx; size_t vb;
  if (idx < 512) { const int bl = idx >> 7; head = (idx >> 5) & 3; c = idx & 31; L = 4096; nc = 32; ctx = false; m0 = bl * 4096 + c * 128; b = g * 4 + bl; ubase = idx - c; vb = (size_t)bl * 512 * 4096; }
  else { const int r = idx - 512; const int bc = r >> 3; head = (r >> 1) & 3; c = r & 1; L = 256; nc = 2; ctx = true; m0 = TLG + bc * 256 + c * 128; b = bc; ubase = idx - c; vb = 4ull * 512 * 4096 + (size_t)bc * 512 * 256; }
  const float xf = p.in[I_RDEC][l * 8 + head], xb = p.in[I_RDEC][l * 8 + 4 + head];
  const float lgf = -log1pf(expf(-xf)) * LOG2E, lgb = -log1pf(expf(-xb)) * LOG2E;
  const float* U = (const float*)(p.ws + OFF_U) + (size_t)ubase * 2 * 8192;
  bf16_t* sRf = (bf16_t*)smem;
  bf16_t* sRb = sRf + 128 * 72;
  {
    const float* uc = U + (size_t)c * 2 * 8192;
#pragma unroll
    for (int i = 0; i < 8; ++i) {
      const int id = (tid + 256 * i) * 4, e = id >> 6, d = id & 63;
      const float4 a = *(const float4*)(uc + id);
      const float4 bq = *(const float4*)(uc + 8192 + id);
      uint2 ua, ub; ua.x = pk2(a.x, a.y); ua.y = pk2(a.z, a.w); ub.x = pk2(bq.x, bq.y); ub.y = pk2(bq.z, bq.w);
      *(uint2*)(sRf + e * 72 + d) = ua;
      *(uint2*)(sRb + e * 72 + d) = ub;
    }
  }
  __syncthreads();
  const int iq = wave * 32 + lr;
  const int m = m0 + iq;
  const bf16_t* Qp = (const bf16_t*)(p.ws + OFF_RQ) + (size_t)m * 256 + head * 64;
  bf16x8 q[4];
#pragma unroll
  for (int ks = 0; ks < 4; ++ks) q[ks] = *(const bf16x8*)(Qp + ks * 16 + lh * 8);
  f32x16 O[4];
  {
    const float qdf = exp2f(lgf * (float)(iq + 1)), qdb = exp2f(lgb * (float)(128 - iq));
#pragma unroll
    for (int et = 0; et < 4; ++et) {
      f32x16 xf_, xb_;
#pragma unroll
      for (int i = 0; i < 16; ++i) { xf_[i] = 0.f; xb_[i] = 0.f; }
#pragma unroll
      for (int ks = 0; ks < 4; ++ks) {
        const bf16x8 a = *(const bf16x8*)(sRf + (et * 32 + lr) * 72 + ks * 16 + lh * 8);
        const bf16x8 a2 = *(const bf16x8*)(sRb + (et * 32 + lr) * 72 + ks * 16 + lh * 8);
        xf_ = MFMA(a, q[ks], xf_);
        xb_ = MFMA(a2, q[ks], xb_);
      }
#pragma unroll
      for (int i = 0; i < 16; ++i) O[et][i] = qdf * xf_[i] + qdb * xb_[i];
    }
  }
  __syncthreads();
  bf16_t* sK = (bf16_t*)smem;
  bf16_t* sV = sK + 128 * 72;
  {
    const bf16_t* Kp = (const bf16_t*)(p.ws + OFF_RK) + (size_t)m0 * 256 + head * 64;
    const bf16_t* Vt = (const bf16_t*)(p.ws + OFF_RVT) + vb + (size_t)(head * 128) * L + c * 128;
#pragma unroll
    for (int i = 0; i < 4; ++i) { const int ci = tid + 256 * i; *(uint4*)(sK + (ci >> 3) * 72 + (ci & 7) * 8) = *(const uint4*)(Kp + (size_t)(ci >> 3) * 256 + (ci & 7) * 8); }
#pragma unroll
    for (int i = 0; i < 8; ++i) { const int ci = tid + 256 * i; *(uint4*)(sV + (ci >> 4) * 136 + (ci & 15) * 8) = *(const uint4*)(Vt + (size_t)(ci >> 4) * L + (ci & 15) * 8); }
  }
  __syncthreads();
  const int prow = perm23(lr);
#pragma unroll 1
  for (int kt = 0; kt < 4; ++kt) {
    f32x16 S;
#pragma unroll
    for (int i = 0; i < 16; ++i) S[i] = 0.f;
#pragma unroll
    for (int ks = 0; ks < 4; ++ks) {
      const bf16x8 a = *(const bf16x8*)(sK + (kt * 32 + prow) * 72 + ks * 16 + lh * 8);
      S = MFMA(a, q[ks], S);
    }
#pragma unroll
    for (int i = 0; i < 16; ++i) {
      const int j = kt * 32 + 16 * (i >> 3) + 8 * lh + (i & 7);
      const int dl = iq - j;
      S[i] *= (dl >= 0) ? exp2f(lgf * (float)dl) : exp2f(lgb * (float)(-dl));
    }
#pragma unroll
    for (int s = 0; s < 2; ++s) {
      uint4 u;
      u.x = pk2(S[8 * s + 0], S[8 * s + 1]); u.y = pk2(S[8 * s + 2], S[8 * s + 3]);
      u.z = pk2(S[8 * s + 4], S[8 * s + 5]); u.w = pk2(S[8 * s + 6], S[8 * s + 7]);
      const bf16x8 pf = __builtin_bit_cast(bf16x8, u);
#pragma unroll
      for (int et = 0; et < 4; ++et) {
        const bf16x8 a = *(const bf16x8*)(sV + (et * 32 + lr) * 136 + kt * 32 + s * 16 + lh * 8);
        O[et] = MFMA(a, pf, O[et]);
      }
    }
  }
  float ss = 0.f;
#pragma unroll
  for (int et = 0; et < 4; ++et)
#pragma unroll
    for (int i = 0; i < 16; ++i) ss += O[et][i] * O[et][i];
  ss = wave_half_sum(ss);
  const float rstd = rsqrtf(ss * (1.f / 128.f) + EPS);
  const float* gn = p.in[I_RGN] + l * 128;
  const bf16_t* rg = (const bf16_t*)(p.ws + OFF_RG) + (size_t)m * 512 + head * 128;
  bf16_t* d = (bf16_t*)(p.ws + OFF_ORR) + (size_t)m * LDO + head * 128;
#pragma unroll
  for (int et = 0; et < 4; ++et) {
    float v[16];
#pragma unroll
    for (int q4 = 0; q4 < 4; ++q4) {
      const uint2 u = *(const uint2*)(rg + et * 32 + q4 * 8 + lh * 4);
      const float gg[4] = {bflo(u.x), bfhi(u.x), bflo(u.y), bfhi(u.y)};
#pragma unroll
      for (int e = 0; e < 4; ++e) {
        const int i = q4 * 4 + e;
        const float sg = gg[e] / (1.f + expf(-gg[e]));
        v[i] = O[et][i] * rstd * gn[et * 32 + q4 * 8 + lh * 4 + e] * sg;
      }
    }
    store_sub_bf16(d + et * 32, v, lh);
  }
  __syncthreads();
}

DI void p4_phase(const Params& p, int g, int l, char* smem, int* s_item) {
  int* ctr = (int*)(p.ws + OFF_CTR) + (g * 2 + l);
  const int n_lat = 512;
  const int n_ret = g == 0 ? 640 : 512;
  const int n_cx = g == 0 ? 128 : 0;
  const int n_w = (g == 0 && l == 0) ? W_TILES : 0;
  const int total = 2 * n_lat + n_ret + 2 * n_cx + n_w;
  while (true) {
    if (threadIdx.x == 0) *s_item = atomicAdd(ctr, 1);
    __syncthreads();
    int t = *s_item;
    __syncthreads();
    if (t >= total) break;
    if (t < n_lat) attn_mla_item(p, l, false, t >> 7, (t >> 5) & 3, t & 31, smem);
    else if ((t -= n_lat) < n_lat) attn_diff_item(p, l, false, t >> 7, (t >> 5) & 3, t & 31, smem);
    else if ((t -= n_lat) < n_ret) ret_out_item(p, g, l, t, smem);
    else if ((t -= n_ret) < n_cx) attn_mla_item(p, l, true, t >> 3, (t >> 1) & 3, t & 1, smem);
    else if ((t -= n_cx) < n_cx) attn_diff_item(p, l, true, t >> 3, (t >> 1) & 3, t & 1, smem);
    else { t -= n_cx; weight_tile(p, 1, t, smem); }
  }
}

template <int FT>
DI void p5_tile(const Params& p, int l, int mt, int nt, char* smem) {
  const bf16_t* H = (const bf16_t*)(p.ws + OFF_H);
  const bf16_t* Wl = (const bf16_t*)(p.ws + OFF_W) + (size_t)l * W_LAYER;
  bf16_t* MG = (bf16_t*)(p.ws + OFF_MERGED);
  const int tid = opaque_tid(), lane = tid & 63, wave = tid >> 6, wt = wave >> 1, wf = wave & 1, lr = lane & 31, lh = lane >> 5;
  const int m0 = mt * 128, n0 = nt * (64 * FT);
  unsigned mgp[2][FT][8];
#pragma unroll
  for (int a = 0; a < 2; ++a)
#pragma unroll
    for (int b = 0; b < FT; ++b)
#pragma unroll
      for (int i = 0; i < 8; ++i) mgp[a][b][i] = 0u;
#pragma unroll 1
  for (int br = 0; br < 3; ++br) {
    unsigned sg[2][FT][8];
    {
      f32x16 ag[2][FT];
      zero_acc<2, FT>(ag);
      gemm_mainloop<2, 2, 2, FT, 64, 1>(H + (size_t)m0 * LDH, LDH, Wl + WO_IN + (size_t)(NZ + br * 1024 + n0) * LW1, LW1, 1024, ag, smem);
#pragma unroll
      for (int a = 0; a < 2; ++a)
#pragma unroll
        for (int b = 0; b < FT; ++b)
#pragma unroll
          for (int i = 0; i < 8; ++i)
            sg[a][b][i] = pk2(1.f / (1.f + __expf(-ag[a][b][2 * i])), 1.f / (1.f + __expf(-ag[a][b][2 * i + 1])));
    }
    f32x16 ao[2][FT];
    zero_acc<2, FT>(ao);
    const bf16_t* Ob = (const bf16_t*)(p.ws + (br == 0 ? OFF_DQ : (br == 1 ? OFF_ORR : OFF_OM)));
    gemm_mainloop<2, 2, 2, FT, 64, 1>(Ob + (size_t)m0 * LDO, LDO, Wl + WO_BR + (size_t)br * 1024 * LWBR + (size_t)n0 * LWBR, LWBR, 512, ao, smem);
#pragma unroll
    for (int a = 0; a < 2; ++a)
#pragma unroll
      for (int b = 0; b < FT; ++b)
#pragma unroll
        for (int i = 0; i < 8; ++i)
          mgp[a][b][i] = pk2(bflo(mgp[a][b][i]) + bflo(sg[a][b][i]) * ao[a][b][2 * i], bfhi(mgp[a][b][i]) + bfhi(sg[a][b][i]) * ao[a][b][2 * i + 1]);
  }
#pragma unroll
  for (int tt = 0; tt < 2; ++tt) {
    const int m = m0 + wt * 64 + tt * 32 + lr;
#pragma unroll
    for (int ft = 0; ft < FT; ++ft) {
      bf16_t* d = MG + (size_t)m * LDM + n0 + wf * (32 * FT) + ft * 32;
#pragma unroll
      for (int q = 0; q < 4; ++q) { uint2 u; u.x = mgp[tt][ft][q * 2]; u.y = mgp[tt][ft][q * 2 + 1]; *(uint2*)(d + q * 8 + lh * 4) = u; }
    }
  }
}

DI void p5_phase(const Params& p, int g, int l, char* smem) {
  for (int it = 0;; ++it) {
    int mt, nt;
    if (!tile_map<8>(it, 128, mt, nt)) break;
    p5_tile<2>(p, l, mt, nt, smem);
  }
  if (g == 0) {
    for (int it = 0;; ++it) {
      int mt, nt;
      if (!tile_map<16>(it, 32, mt, nt)) break;
      p5_tile<1>(p, l, 128 + mt, nt, smem);
    }
  }
}

template <int FT>
DI void resid_tile(const Params& p, int g, int l, int mode, int mt, int nt, char* smem) {
  const float* xin_p = p.in[I_XP]; const float* xin_s = p.in[I_XS];
  asm volatile("" : "+s"(xin_p), "+s"(xin_s));
  const int tid = opaque_tid(), lane = tid & 63, wave = tid >> 6, wt = wave >> 1, wf = wave & 1, lr = lane & 31, lh = lane >> 5;
  const bf16_t* Wl = (const bf16_t*)(p.ws + OFF_W) + (size_t)l * W_LAYER;
  const bf16_t* A = (const bf16_t*)(p.ws + (mode == 0 ? OFF_MERGED : OFF_UMLP));
  const int K = mode == 0 ? 1024 : 4096;
  const int lda = mode == 0 ? LDM : LDU, ldb = mode == 0 ? LW1 : LWDN;
  const bf16_t* B = Wl + (mode == 0 ? WO_OUT : WO_DN);
  const float* mod = (const float*)(p.ws + OFF_MOD);
  const int m0 = mt * 128, n0 = nt * (64 * FT);
  f32x16 acc[2][FT];
  zero_acc<2, FT>(acc);
  gemm_mainloop<2, 2, 2, FT, (FT == 4 ? 32 : 64), 1>(A + (size_t)m0 * lda, lda, B + (size_t)n0 * ldb, ldb, K, acc, smem);
#pragma unroll
  for (int tt = 0; tt < 2; ++tt) {
    const int m = m0 + wt * 64 + tt * 32 + lr;
    const Tok t = tokinfo(g, m);
    const float* gate = mod + (size_t)(l * 9 + t.cond) * 6144 + (mode == 0 ? 2048 : 5120);
    float* y = p.out + (t.ctx ? O_YP : O_YS) + t.xrow * 1024;
    const float* x = (mode == 0 && l == 0) ? ((t.ctx ? xin_p : xin_s) + t.xrow * 1024) : y;
#pragma unroll
    for (int ft = 0; ft < FT; ++ft)
#pragma unroll
      for (int q = 0; q < 4; ++q) {
        const int f = n0 + wf * (32 * FT) + ft * 32 + q * 8 + lh * 4;
        const float4 xv = *(const float4*)(x + f);
        const float4 gv = *(const float4*)(gate + f);
        float4 o;
        o.x = xv.x + gv.x * acc[tt][ft][q * 4 + 0]; o.y = xv.y + gv.y * acc[tt][ft][q * 4 + 1];
        o.z = xv.z + gv.z * acc[tt][ft][q * 4 + 2]; o.w = xv.w + gv.w * acc[tt][ft][q * 4 + 3];
        *(float4*)(y + f) = o;
      }
  }
}

DI void resid_gemm_phase(const Params& p, int g, int l, int mode, char* smem) {
  for (int it = 0;; ++it) {
    int mt, nt;
    if (!tile_map<4>(it, 128, mt, nt)) break;
    resid_tile<4>(p, g, l, mode, mt, nt, smem);
  }
  if (g == 0) {
    for (int it = 0;; ++it) {
      int mt, nt;
      if (!tile_map<8>(it, 32, mt, nt)) break;
      resid_tile<2>(p, g, l, mode, 128 + mt, nt, smem);
    }
  }
}

DI void up_phase(const Params& p, int g, int l, char* smem) {
  const int Tg = g == 0 ? TG : TLG;
  const int MT = Tg / 128;
  const bf16_t* H = (const bf16_t*)(p.ws + OFF_H);
  const bf16_t* B = (const bf16_t*)(p.ws + OFF_W) + (size_t)l * W_LAYER + WO_UP;
  bf16_t* Uo = (bf16_t*)(p.ws + OFF_UMLP);
  bf16_t* sT = (bf16_t*)smem;
  for (int it = 0;; ++it) {
    int mt, nt;
    if (!tile_map<16>(it, MT, mt, nt)) break;
    const int tid = opaque_tid(), lane = tid & 63, wave = tid >> 6, wt = wave >> 1, wf = wave & 1, lr = lane & 31, lh = lane >> 5;
    const int m0 = mt * 128, n0 = nt * 256;
    f32x16 acc[2][4];
    zero_acc<2, 4>(acc);
    gemm_mainloop<2, 2, 2, 4, 32, 1>(H + (size_t)m0 * LDH, LDH, B + (size_t)n0 * LW1, LW1, 1024, acc, smem);
#pragma unroll
    for (int tt = 0; tt < 2; ++tt) {
      const int r = wt * 64 + tt * 32 + lr;
#pragma unroll
      for (int ft = 0; ft < 4; ++ft) {
        float v[16];
#pragma unroll
        for (int i = 0; i < 16; ++i) { const float x = fmaxf(acc[tt][ft][i], 0.f); v[i] = x * x; }
        store_sub_bf16(sT + r * 264 + wf * 128 + ft * 32, v, lh);
      }
    }
    __syncthreads();
#pragma unroll
    for (int i = 0; i < 16; ++i) {
      const int ci = tid + 256 * i, r = ci >> 5, c = (ci & 31) * 8;
      *(uint4*)(Uo + (size_t)(m0 + r) * LDU + n0 + c) = *(const uint4*)(sT + r * 264 + c);
    }
    __syncthreads();
  }
}

__global__ void __launch_bounds__(256, 2) fwd_megakernel(Params p) {
  cg::grid_group grid = cg::this_grid();
  __shared__ __attribute__((aligned(16))) char smem[73728];
  __shared__ int s_item;
  __shared__ uint4 xb_words;
  if (threadIdx.x == 0) xb_words = make_uint4(0u, 0u, 0u, 0u);
  __syncthreads();
  const XcdBarrier xb = xcd_barrier_post((unsigned*)(p.ws + OFF_BAR), (volatile unsigned*)&xb_words);
  prep_phase(p, smem);
  if (p.ws == nullptr) grid.sync();
  xcd_barrier(xb);
#pragma unroll 1
  for (int g0 = 0; g0 < 2; ++g0) {
#pragma unroll 1
    for (int l0 = 0; l0 < 2; ++l0) {
#define PHASE_GL int g = g0, l = l0; asm volatile("" : "+s"(g), "+s"(l));
      { PHASE_GL rownorm_phase(p, g, l, 0); cache_convert(p, g, l, smem); }
      xcd_barrier(xb);
      { PHASE_GL gemm1_phase(p, g, l, smem); }
      xcd_barrier(xb);
      { PHASE_GL p3_phase(p, g, l, smem); }
      xcd_barrier(xb);
      { PHASE_GL ret_scan_phase(p, g, l); }
      xcd_barrier(xb);
      { PHASE_GL p4_phase(p, g, l, smem, &s_item); }
      xcd_barrier(xb);
      { PHASE_GL p5_phase(p, g, l, smem); }
      xcd_barrier(xb);
#if PROBE_P5
      { PHASE_GL p5_phase(p, g, l, smem); }
      xcd_barrier(xb);
#endif
#if PROBE_G1
      { PHASE_GL gemm1_phase(p, g, l, smem); }
      xcd_barrier(xb);
#endif
#if PROBE_SYNC2
      xcd_barrier(xb); xcd_barrier(xb); xcd_barrier(xb); xcd_barrier(xb); xcd_barrier(xb); xcd_barrier(xb); xcd_barrier(xb); xcd_barrier(xb); xcd_barrier(xb);
#endif
      { PHASE_GL resid_gemm_phase(p, g, l, 0, smem); }
      xcd_barrier(xb);
      { PHASE_GL rownorm_phase(p, g, l, 1); }
      xcd_barrier(xb);
      { PHASE_GL up_phase(p, g, l, smem); }
      xcd_barrier(xb);
#if PROBE_UP2
      { PHASE_GL up_phase(p, g, l, smem); }
      xcd_barrier(xb);
#endif
      { PHASE_GL resid_gemm_phase(p, g, l, 1, smem); }
      xcd_barrier(xb);
    }
  }
}

extern "C" void kernel_launch(void* const* d_in, const int* in_sizes, int n_in, void* d_out,
                              int out_size, void* d_ws, size_t ws_size, hipStream_t stream) {
  static int grid_blocks = 0;
  if (!grid_blocks) {
    int dev = 0, cus = 0, per_cu = 0;
    (void)hipGetDevice(&dev);
    (void)hipDeviceGetAttribute(&cus, hipDeviceAttributeMultiprocessorCount, dev);
    (void)hipOccupancyMaxActiveBlocksPerMultiprocessor(&per_cu, fwd_megakernel, 256, 0);
    if (per_cu > 2) per_cu = 2;
    if (per_cu < 1) per_cu = 1;
    grid_blocks = cus * per_cu;
    if (grid_blocks > 640) grid_blocks = 640;
  }
  Params p{};
  for (int i = 0; i < 30; ++i) p.in[i] = (const float*)d_in[i];
  p.out = (float*)d_out;
  p.ws = (char*)d_ws;
  (void)hipMemsetAsync((char*)d_ws + OFF_CTR, 0, OFF_SSQ - OFF_CTR, stream);
  void* args[] = {&p};
  hipError_t e = hipLaunchCooperativeKernel((void*)fwd_megakernel, dim3(grid_blocks), dim3(256), args, 0, stream);
  if (e != hipSuccess) fprintf(stderr, "cooperative launch failed: %s (grid %d)\n", hipGetErrorString(e), grid_blocks);
}
```

```cpp
#include <hip/hip_runtime.h>
#include <hip/hip_cooperative_groups.h>
#include <cstdio>
namespace cg = cooperative_groups;

typedef unsigned short bf16_t;
typedef __bf16 bf16x2_t __attribute__((ext_vector_type(2)));
typedef float f32x2_t __attribute__((ext_vector_type(2)));
using bf16x8 = __attribute__((ext_vector_type(8))) short;
using f32x16 = __attribute__((ext_vector_type(16))) float;
using u32x4 = __attribute__((ext_vector_type(4))) unsigned;
#define DI __device__ __forceinline__
#define MFMA(a, b, c) __builtin_amdgcn_mfma_f32_32x32x16_bf16((a), (b), (c), 0, 0, 0)

DI unsigned pk2(float a, float b) { f32x2_t v = {a, b}; return __builtin_bit_cast(unsigned, __builtin_convertvector(v, bf16x2_t)); }
DI bf16_t f2bf(float a) { return (bf16_t)(pk2(a, 0.f) & 0xffffu); }
DI float bflo(unsigned u) { return __uint_as_float(u << 16); }
DI float bfhi(unsigned u) { return __uint_as_float(u & 0xffff0000u); }

#ifndef PROBE_MLA2
#define PROBE_MLA2 0
#endif
#ifndef PROBE_P5
#define PROBE_P5 0
#endif
#ifndef PROBE_G1
#define PROBE_G1 0
#endif
#ifndef PROBE_UP2
#define PROBE_UP2 0
#endif
#ifndef PROBE_SYNC2
#define PROBE_SYNC2 0
#endif
constexpr int NZ = 3776;
constexpr int TG = 20480;
constexpr int TLG = 16384;
constexpr int KVR = 22528;
constexpr float EPS = 1e-6f;
constexpr float LOG2E = 1.4426950408889634f;

constexpr int LDH = 1088, LDU = 4160, LDM = 1088, LDO = 576;
constexpr int LW1 = 1088, LWQB = 448, LWKVB = 320, LWBR = 576, LWDN = 4160;
constexpr size_t W_IN = 6848ull * LW1, W_QB = 768ull * LWQB, W_KVB = 1024ull * LWKVB, W_BR = 3ull * 1024 * LWBR,
                 W_OUT = 1024ull * LW1, W_UP = 4096ull * LW1, W_DN = 1024ull * LWDN;
constexpr size_t WO_IN = 0, WO_QB = WO_IN + W_IN, WO_KVB = WO_QB + W_QB, WO_BR = WO_KVB + W_KVB, WO_OUT = WO_BR + W_BR,
                 WO_UP = WO_OUT + W_OUT, WO_DN = WO_UP + W_UP, W_LAYER = WO_DN + W_DN;

constexpr size_t al(size_t x) { return (x + 255) & ~(size_t)255; }
constexpr size_t OFF_W = 0;
constexpr size_t OFF_MOD = al(OFF_W + 2 * W_LAYER * 2);
constexpr size_t OFF_ROPE = al(OFF_MOD + 2 * 9 * 6144 * 4);
constexpr size_t OFF_SCAL = al(OFF_ROPE + 2048 * 4);
constexpr size_t OFF_CTR = al(OFF_SCAL + 256);
constexpr size_t OFF_BAR = al(OFF_CTR + 256);
constexpr size_t OFF_SSQ = al(OFF_BAR + 3456 * 4);
constexpr size_t OFF_H = al(OFF_SSQ + (size_t)TG * 16 * 4);
constexpr size_t OFF_DQ = al(OFF_H + (size_t)TG * LDH * 2);
constexpr size_t OFF_RQ = al(OFF_DQ + (size_t)TG * LDO * 2);
constexpr size_t OFF_RK = al(OFF_RQ + (size_t)TG * 256 * 2);
constexpr size_t OFF_RKT = al(OFF_RK + (size_t)TG * 256 * 2);
constexpr size_t OFF_RVT = al(OFF_RKT + (size_t)TG * 256 * 2);
constexpr size_t OFF_RG = al(OFF_RVT + (size_t)TG * 512 * 2);
constexpr size_t OFF_MQ = al(OFF_RG + (size_t)TG * 512 * 2);
constexpr size_t OFF_OM = al(OFF_MQ + (size_t)TG * 768 * 2);
constexpr size_t OFF_ORR = al(OFF_OM + (size_t)TG * LDO * 2);
constexpr size_t OFF_MQA = al(OFF_ORR + (size_t)TG * LDO * 2);
constexpr size_t OFF_MKVA = al(OFF_MQA + (size_t)TG * 384 * 2);
constexpr size_t OFF_MKR = al(OFF_MKVA + (size_t)TG * 256 * 2);
constexpr size_t OFF_CKVA = al(OFF_MKR + (size_t)TG * 64 * 2);
constexpr size_t OFF_CKR = al(OFF_CKVA + 2048ull * 256 * 2);
constexpr size_t OFF_DK = al(OFF_CKR + 2048ull * 64 * 2);
constexpr size_t OFF_DVT = al(OFF_DK + (size_t)KVR * 512 * 2);
constexpr size_t OFF_MK = al(OFF_DVT + (size_t)KVR * 512 * 2);
constexpr size_t OFF_MVT = al(OFF_MK + (size_t)KVR * 768 * 2);
constexpr size_t OFF_U = al(OFF_MVT + (size_t)KVR * 512 * 2);
constexpr size_t OFF_O0 = al(OFF_U + 640ull * 2 * 8192 * 4);
constexpr size_t OFF_END = al(OFF_O0 + 640ull * 64 * 256 * 4);
constexpr size_t OFF_MERGED = OFF_DK;
constexpr size_t OFF_UMLP = OFF_DQ;
static_assert((size_t)TG * LDM * 2 <= OFF_MK - OFF_DK, "merged alias");
static_assert((size_t)TG * LDU * 2 <= OFF_DK - OFF_DQ, "umlp alias");
static_assert(OFF_END <= 512ull * 1024 * 1024, "workspace");

constexpr size_t O_YP = 0, O_YS = 4194304, O_NDK = 37748736, O_NDV = 41943040, O_NCKV = 46137344, O_NKR = 48234496, O_NSR = 48758784;

struct Params {
  const float* in[30];
  float* out;
  char* ws;
};
enum { I_XP = 0, I_XS, I_CDK, I_CDV, I_CCKV, I_CKR, I_SR, I_C, I_CCTX, I_WMOD, I_BMOD, I_N1, I_N2, I_WIN, I_DQN, I_DKN, I_DLAM,
       I_DSUB, I_RDEC, I_RGN, I_QAN, I_WQB, I_KVAN, I_WKVB, I_MQN, I_MKN, I_WBR, I_WOUT, I_WUP, I_WDN };

struct Tok { int ctx, b, n, cond, bl, kvrow; size_t xrow; };
DI Tok tokinfo(int g, int m) {
  Tok t;
  if (m < TLG) { int tl = g * TLG + m; t.ctx = 0; t.b = tl >> 12; t.n = tl & 4095; t.cond = 1 + t.b; t.xrow = tl; t.bl = m >> 12; t.kvrow = t.bl * 4608 + t.n; }
  else { int tc = m - TLG; t.ctx = 1; t.b = tc >> 8; t.n = tc & 255; t.cond = 0; t.xrow = tc; t.bl = 0; t.kvrow = 18432 + tc; }
  return t;
}
DI size_t vt_base(const Tok& t) { return t.ctx ? (4ull * 512 * 4608 + (size_t)t.b * 512 * 256) : ((size_t)t.bl * 512 * 4608); }
DI int vt_L(const Tok& t) { return t.ctx ? 256 : 4608; }
DI size_t rvt_base(const Tok& t) { return t.ctx ? (4ull * 512 * 4096 + (size_t)t.b * 512 * 256) : ((size_t)t.bl * 512 * 4096); }
DI size_t rkt_base(const Tok& t) { return t.ctx ? (4ull * 256 * 4096 + (size_t)t.b * 256 * 256) : ((size_t)t.bl * 256 * 4096); }
DI int r_L(const Tok& t) { return t.ctx ? 256 : 4096; }

DI int opaque_tid() { int t = threadIdx.x; asm volatile("" : "+v"(t)); return t; }
DI int perm23(int r) { return (r & 0x13) | ((r & 4) << 1) | ((r & 8) >> 1); }
DI float wave_half_sum(float v) { return v + __shfl_xor(v, 32); }


#define XB_TMO      128
#define XB_XCNT(j)  (256  + 64 * (j))
#define XB_XSUB(j)  (1280 + 64 * (j))
#define XB_XGEN(j)  (2304 + 64 * (j))
#define XB_TOP      3328
#define XB_TOPGEN   3392
#define XCD_BAR_WORDS 3456
#define XB_SPIN_CAP (1u << 18)
DI unsigned xb_ld(unsigned* p) { return __hip_atomic_load(p, __ATOMIC_RELAXED, __HIP_MEMORY_SCOPE_AGENT); }
DI unsigned xb_add(unsigned* p, unsigned v) { return __hip_atomic_fetch_add(p, v, __ATOMIC_RELAXED, __HIP_MEMORY_SCOPE_AGENT); }
DI unsigned xb_xcc_id() { return (unsigned)__builtin_amdgcn_s_getreg((3 << 11) | 20) & 0xFu; }
#define XB_SPIN(cond, bar) do { unsigned _sp = 0; while (cond) { __builtin_amdgcn_s_sleep(1); \
    if ((++_sp & 255u) == 0u) { if (xb_ld(&(bar)[XB_TMO])) break; if (_sp > XB_SPIN_CAP) { atomicAdd(&(bar)[XB_TMO], 1u); break; } } } } while (0)
struct XcdBarrier { unsigned* bar; unsigned x; volatile unsigned* st; };
DI XcdBarrier xcd_barrier_post(unsigned* bar, volatile unsigned* st) {
  XcdBarrier b; b.bar = bar; b.x = xb_xcc_id(); b.st = st;
  if (threadIdx.x == 0) (void)xb_add(&bar[XB_XCNT(b.x)], 1u);
  return b;
}
DI void xcd_barrier_complete(unsigned* bar, unsigned x, unsigned& nloc, unsigned& nx) {
  const unsigned G = gridDim.x * gridDim.y * gridDim.z;
  unsigned sum, cnt, mine, sp = 0u;
  for (;;) {
    sum = 0u; cnt = 0u; mine = 0u;
#pragma unroll
    for (unsigned j = 0; j < 16; ++j) { const unsigned c = xb_ld(&bar[XB_XCNT(j)]); sum += c; cnt += (c > 0u) ? 1u : 0u; mine = (j == x) ? c : mine; }
    if (sum == G) break;
    __builtin_amdgcn_s_sleep(1);
    if ((++sp & 255u) == 0u) { if (xb_ld(&bar[XB_TMO])) break; if (sp > XB_SPIN_CAP) { atomicAdd(&bar[XB_TMO], 1u); break; } }
  }
  nloc = mine > 0u ? mine : 1u; nx = cnt > 0u ? cnt : 1u;
}
DI void xcd_barrier(const XcdBarrier& b) {
  asm volatile("s_waitcnt vmcnt(0)" ::: "memory");
  __syncthreads();
  if (threadIdx.x == 0) {
    unsigned* bar = b.bar;
    __builtin_amdgcn_s_waitcnt(0);
    unsigned nloc = b.st[0], nx = b.st[1];
    if (nloc == 0u) { xcd_barrier_complete(bar, b.x, nloc, nx); b.st[0] = nloc; b.st[1] = nx; }
    const unsigned old = xb_add(&bar[XB_XSUB(b.x)], 1u);
    const unsigned gen = old / nloc;
    if (old + 1u == (gen + 1u) * nloc) {
      __builtin_amdgcn_fence(__ATOMIC_RELEASE, "agent");
      asm volatile("s_waitcnt vmcnt(0)" ::: "memory");
      const unsigned og = xb_add(&bar[XB_TOP], 1u);
      const unsigned tg = og / nx;
      if (og + 1u == (tg + 1u) * nx) xb_add(&bar[XB_TOPGEN], 1u);
      else XB_SPIN(xb_ld(&bar[XB_TOPGEN]) == tg, bar);
      __builtin_amdgcn_fence(__ATOMIC_ACQUIRE, "agent");
      xb_add(&bar[XB_XGEN(b.x)], 1u);
      asm volatile("s_waitcnt vmcnt(0)" ::: "memory");
    } else {
      XB_SPIN(xb_ld(&bar[XB_XGEN(b.x)]) == gen, bar);
      __builtin_amdgcn_fence(__ATOMIC_ACQUIRE, "agent");
      asm volatile("s_waitcnt vmcnt(0)" ::: "memory");
    }
  }
  __syncthreads();
}

template <int BK> DI int lds_sw(int row) { return BK == 32 ? ((row >> 2) & 3) : ((row >> 1) & 7); }
template <int WT, int WF, int TT, int FT, int BK = 64, int D = 2>
DI void gemm_mainloop(const bf16_t* __restrict__ At, int lda, const bf16_t* __restrict__ Bf, int ldb, int K, f32x16 (&acc)[TT][FT], char* smem) {
  constexpr int BM = WT * TT * 32, BN = WF * FT * 32, LS = BK, CPR = BK / 8, RPP = 256 / CPR, NA = BM / RPP, NB = BN / RPP, STAGE = (BM + BN) * LS, KS = BK / 16;
  static_assert(2 * STAGE * 2 <= 73728, "LDS stages");
  static_assert(D == 1 || D == 2 || D == 4, "depth");
  const int tid = opaque_tid(), lane = tid & 63, wave = tid >> 6, wt = wave / WF, wf = wave % WF, lr = lane & 31, lh = lane >> 5;
  const int c8 = (tid % CPR) * 8, r0 = tid / CPR;
  const bf16_t* ap = At + (size_t)r0 * lda + c8;
  const bf16_t* bp = Bf + (size_t)r0 * ldb + c8;
  bf16_t* wA = (bf16_t*)smem + r0 * LS + (((tid % CPR) ^ lds_sw<BK>(r0)) * 8);
  bf16_t* wB = wA + BM * LS;
  int rof[KS];
#pragma unroll
  for (int ks = 0; ks < KS; ++ks) rof[ks] = ((ks * 2 + lh) ^ lds_sw<BK>(lr)) * 8;
  const bf16_t* rB = (const bf16_t*)smem + BM * LS + (wf * FT * 32 + lr) * LS;
  const bf16_t* rA = (const bf16_t*)smem + (wt * TT * 32 + lr) * LS;
  u32x4 ra[D][NA], rb[D][NB];
  const int nk = K / BK;
#pragma unroll
  for (int i = 0; i < NA; ++i) ra[0][i] = *(const u32x4*)(ap + (size_t)i * RPP * lda);
#pragma unroll
  for (int i = 0; i < NB; ++i) rb[0][i] = *(const u32x4*)(bp + (size_t)i * RPP * ldb);
#pragma unroll
  for (int i = 0; i < NA; ++i) *(u32x4*)(wA + RPP * i * LS) = ra[0][i];
#pragma unroll
  for (int i = 0; i < NB; ++i) *(u32x4*)(wB + RPP * i * LS) = rb[0][i];
#pragma unroll
  for (int d = 0; d < D; ++d) {
    if (1 + d < nk) {
      const int ko = (1 + d) * BK;
#pragma unroll
      for (int i = 0; i < NA; ++i) ra[d][i] = *(const u32x4*)(ap + (size_t)i * RPP * lda + ko);
#pragma unroll
      for (int i = 0; i < NB; ++i) rb[d][i] = *(const u32x4*)(bp + (size_t)i * RPP * ldb + ko);
    }
  }
  __syncthreads();
  for (int kb = 0; kb < nk; kb += D) {
#pragma unroll
    for (int j = 0; j < D; ++j) {
      const int kt = kb + j;
      const int so = (D == 1 ? (kt & 1) : (j & 1)) * STAGE;
#pragma unroll
      for (int ks = 0; ks < KS; ++ks) {
        bf16x8 fa[FT], tb[TT];
#pragma unroll
        for (int ft = 0; ft < FT; ++ft) fa[ft] = *(const bf16x8*)(rB + so + ft * 32 * LS + rof[ks]);
#pragma unroll
        for (int tt = 0; tt < TT; ++tt) tb[tt] = *(const bf16x8*)(rA + so + tt * 32 * LS + rof[ks]);
#pragma unroll
        for (int tt = 0; tt < TT; ++tt)
#pragma unroll
          for (int ft = 0; ft < FT; ++ft) acc[tt][ft] = MFMA(fa[ft], tb[tt], acc[tt][ft]);
      }
      if (kt + 1 < nk) {
        const int wo = STAGE - so;
#pragma unroll
        for (int i = 0; i < NA; ++i) *(u32x4*)(wA + wo + RPP * i * LS) = ra[j][i];
#pragma unroll
        for (int i = 0; i < NB; ++i) *(u32x4*)(wB + wo + RPP * i * LS) = rb[j][i];
        if (kt + 1 + D < nk) {
          const int ko = (kt + 1 + D) * BK;
#pragma unroll
          for (int i = 0; i < NA; ++i) ra[j][i] = *(const u32x4*)(ap + (size_t)i * RPP * lda + ko);
#pragma unroll
          for (int i = 0; i < NB; ++i) rb[j][i] = *(const u32x4*)(bp + (size_t)i * RPP * ldb + ko);
        }
      }
      __syncthreads();
    }
  }
}


template <int NT>
DI bool tile_map(int it, int MT, int& mt, int& nt) {
  const int G = gridDim.x, b = blockIdx.x;
  if ((G & 7) != 0) { const int t = b + it * G; mt = t / NT; nt = t % NT; return t < MT * NT; }
  const int x = b & 7, q = (b >> 3) + it * (G >> 3);
  const int bq = q / (NT * 4), rem = q % (NT * 4);
  const int band = x + 8 * bq;
  mt = band * 4 + (rem & 3); nt = rem >> 2;
  return band * 4 < MT;
}

template <int TT, int FT>
DI void zero_acc(f32x16 (&acc)[TT][FT]) {
#pragma unroll
  for (int a = 0; a < TT; ++a)
#pragma unroll
    for (int b = 0; b < FT; ++b)
#pragma unroll
      for (int i = 0; i < 16; ++i) acc[a][b][i] = 0.f;
}

DI void store_sub_bf16(bf16_t* dst, const float (&v)[16], int lh) {
#pragma unroll
  for (int q = 0; q < 4; ++q) {
    uint2 u; u.x = pk2(v[q * 4 + 0], v[q * 4 + 1]); u.y = pk2(v[q * 4 + 2], v[q * 4 + 3]);
    *(uint2*)(dst + q * 8 + lh * 4) = u;
  }
}
DI void store_sub_f32(float* dst, const float (&v)[16], int lh) {
#pragma unroll
  for (int q = 0; q < 4; ++q) *(float4*)(dst + q * 8 + lh * 4) = make_float4(v[q * 4 + 0], v[q * 4 + 1], v[q * 4 + 2], v[q * 4 + 3]);
}
DI void store_sub_T(bf16_t* dstT, size_t L, const float (&v)[16], int lh) {
#pragma unroll
  for (int i = 0; i < 16; ++i) dstT[(size_t)((i & 3) + 8 * (i >> 2) + 4 * lh) * L] = f2bf(v[i]);
}
DI void rope_sub(float (&v)[16], int pos, int lh, const float* tab) {
#pragma unroll
  for (int q = 0; q < 2; ++q) {
    const float4 c = *(const float4*)(tab + pos * 16 + q * 8 + lh * 4);
    const float4 s = *(const float4*)(tab + 1024 + pos * 16 + q * 8 + lh * 4);
    const float cc[4] = {c.x, c.y, c.z, c.w}, ss[4] = {s.x, s.y, s.z, s.w};
#pragma unroll
    for (int e = 0; e < 4; ++e) {
      const float x1 = v[q * 4 + e], x2 = v[q * 4 + e + 8];
      v[q * 4 + e] = x1 * cc[e] - x2 * ss[e];
      v[q * 4 + e + 8] = x2 * cc[e] + x1 * ss[e];
    }
  }
}

DI void transpose_tile(const float* __restrict__ src, bf16_t* __restrict__ dst, int K, int N, int tile, char* smem) {
  const int ldk = K + 64;
  float* s = (float*)smem;
  const int tid_ = opaque_tid();
  const int tn = N >> 6;
  const int k0 = (tile / tn) * 64, n0 = (tile % tn) * 64;
  for (int i = tid_; i < 4096; i += 256) { const int r = i >> 6, c = i & 63; s[r * 65 + c] = src[(size_t)(k0 + r) * N + n0 + c]; }
  __syncthreads();
  for (int i = tid_; i < 512; i += 256) {
    const int n = i >> 3, kc = (i & 7) * 8;
    uint4 v;
    v.x = pk2(s[(kc + 0) * 65 + n], s[(kc + 1) * 65 + n]);
    v.y = pk2(s[(kc + 2) * 65 + n], s[(kc + 3) * 65 + n]);
    v.z = pk2(s[(kc + 4) * 65 + n], s[(kc + 5) * 65 + n]);
    v.w = pk2(s[(kc + 6) * 65 + n], s[(kc + 7) * 65 + n]);
    *(uint4*)(dst + (size_t)(n0 + n) * ldk + k0 + kc) = v;
  }
  __syncthreads();
}

DI void mod_item(const Params& p, int item, char* smem) {
  const int tid = threadIdx.x, lane = tid & 63, wave = tid >> 6;
  const int l = item / 96, n0 = (item % 96) * 64;
  float* sv = (float*)smem;
  for (int i = tid; i < 9 * 1024; i += 256) {
    const int c = i >> 10, k = i & 1023;
    const float v = (c == 0) ? p.in[I_CCTX][k] : p.in[I_C][(c - 1) * 1024 + k];
    sv[i] = v / (1.f + expf(-v));
  }
  __syncthreads();
  float acc[9];
#pragma unroll
  for (int c = 0; c < 9; ++c) acc[c] = 0.f;
  const float* w = p.in[I_WMOD] + (size_t)l * 1024 * 6144 + n0 + lane;
  const int kb = wave * 256;
#pragma unroll 4
  for (int k = kb; k < kb + 256; ++k) {
    const float wv = w[(size_t)k * 6144];
#pragma unroll
    for (int c = 0; c < 9; ++c) acc[c] += sv[c * 1024 + k] * wv;
  }
  float* red = sv + 9 * 1024;
#pragma unroll
  for (int c = 0; c < 9; ++c) red[(wave * 9 + c) * 64 + lane] = acc[c];
  __syncthreads();
  float* mod = (float*)(p.ws + OFF_MOD);
  for (int i = tid; i < 9 * 64; i += 256) {
    const int c = i >> 6, n = i & 63;
    float s = red[(0 * 9 + c) * 64 + n] + red[(1 * 9 + c) * 64 + n] + red[(2 * 9 + c) * 64 + n] + red[(3 * 9 + c) * 64 + n];
    s += p.in[I_BMOD][l * 6144 + n0 + n];
    mod[(size_t)(l * 9 + c) * 6144 + n0 + n] = s;
  }
  __syncthreads();
}

constexpr int W_TILES = 1712 + 72 + 64 + 384 + 256 + 1024 + 1024;
DI void weight_tile(const Params& p, int l, int t, char* smem) {
  bf16_t* W = (bf16_t*)(p.ws + OFF_W);
  bf16_t* Wl = W + (size_t)l * W_LAYER;
  const float* src; bf16_t* dst; int K, N;
  if (t < 1712) { src = p.in[I_WIN] + (size_t)l * 6848 * 1024; dst = Wl + WO_IN; K = 1024; N = 6848; }
  else if ((t -= 1712) < 72) { src = p.in[I_WQB] + (size_t)l * 768 * 384; dst = Wl + WO_QB; K = 384; N = 768; }
  else if ((t -= 72) < 64) { src = p.in[I_WKVB] + (size_t)l * 1024 * 256; dst = Wl + WO_KVB; K = 256; N = 1024; }
  else if ((t -= 64) < 384) { const int i = t / 128; t -= i * 128; src = p.in[I_WBR] + (size_t)l * 3 * 512 * 1024 + (size_t)i * 512 * 1024; dst = Wl + WO_BR + (size_t)i * 1024 * LWBR; K = 512; N = 1024; }
  else if ((t -= 384) < 256) { src = p.in[I_WOUT] + (size_t)l * 1024 * 1024; dst = Wl + WO_OUT; K = 1024; N = 1024; }
  else if ((t -= 256) < 1024) { src = p.in[I_WUP] + (size_t)l * 1024 * 4096; dst = Wl + WO_UP; K = 1024; N = 4096; }
  else { t -= 1024; src = p.in[I_WDN] + (size_t)l * 4096 * 1024; dst = Wl + WO_DN; K = 4096; N = 1024; }
  transpose_tile(src, dst, K, N, t, smem);
}

DI void prep_phase(const Params& p, char* smem) {
  bf16_t* W = (bf16_t*)(p.ws + OFF_W);
  const int tid = threadIdx.x;
  constexpr int N_MOD = 192;
  constexpr int tiles_layer = 1712 + 72 + 64 + 384 + 256 + 1024 + 1024;
  const int total = 1 + N_MOD + tiles_layer;
  for (int item = blockIdx.x; item < total; item += gridDim.x) {
    if (item == 0) {
      float* tab = (float*)(p.ws + OFF_ROPE);
      for (int i = tid; i < 1024; i += 256) {
        const int pos = i >> 4, j = i & 15;
        const float inv = exp2f(-(float)j * (13.287712379549449f / 16.f));
        const float a = (float)pos * inv;
        tab[i] = cosf(a); tab[1024 + i] = sinf(a);
      }
      if (tid < 2) {
        const float* lm = p.in[I_DLAM] + tid * 256;
        float s1 = 0.f, s2 = 0.f;
        for (int k = 0; k < 64; ++k) { s1 += lm[k] * lm[64 + k]; s2 += lm[128 + k] * lm[192 + k]; }
        const float li = 0.8f - 0.6f * expf(-0.3f * (float)tid);
        ((float*)(p.ws + OFF_SCAL))[tid] = expf(s1) - expf(s2) + li;
      }
    } else if (item <= N_MOD) {
      mod_item(p, item - 1, smem);
    } else {
      weight_tile(p, 0, item - 1 - N_MOD, smem);
    }
  }
}

DI void rownorm_phase(const Params& p, int g, int l, int which) {
  const float* xin_p = p.in[I_XP]; const float* xin_s = p.in[I_XS];
  asm volatile("" : "+s"(xin_p), "+s"(xin_s));
  const int Tg = g == 0 ? TG : TLG;
  const int tid_ = opaque_tid();
  const int lane = tid_ & 63, wave = tid_ >> 6;
  const float* mod = (const float*)(p.ws + OFF_MOD);
  bf16_t* H = (bf16_t*)(p.ws + OFF_H);
  const float* gain = p.in[which ? I_N2 : I_N1] + l * 1024;
  for (int m = blockIdx.x * 4 + wave; m < Tg; m += gridDim.x * 4) {
    const Tok t = tokinfo(g, m);
    const float* xr;
    if (which == 0 && l == 0) xr = (t.ctx ? xin_p : xin_s) + t.xrow * 1024;
    else xr = p.out + (t.ctx ? O_YP : O_YS) + t.xrow * 1024;
    float4 v[4];
    float ss = 0.f;
#pragma unroll
    for (int i = 0; i < 4; ++i) { v[i] = ((const float4*)xr)[lane + 64 * i]; ss += v[i].x * v[i].x + v[i].y * v[i].y + v[i].z * v[i].z + v[i].w * v[i].w; }
#pragma unroll
    for (int o = 32; o >= 1; o >>= 1) ss += __shfl_xor(ss, o);
    const float rstd = rsqrtf(ss * (1.f / 1024.f) + EPS);
    const float* mrow = mod + (size_t)(l * 9 + t.cond) * 6144;
    const float* sh = mrow + (which ? 3072 : 0);
    const float* sc = mrow + (which ? 4096 : 1024);
#pragma unroll
    for (int i = 0; i < 4; ++i) {
      const int k = (lane + 64 * i) * 4;
      const float4 gg = *(const float4*)(gain + k), s4 = *(const float4*)(sc + k), h4 = *(const float4*)(sh + k);
      uint2 u;
      u.x = pk2(v[i].x * rstd * gg.x * (1.f + s4.x) + h4.x, v[i].y * rstd * gg.y * (1.f + s4.y) + h4.y);
      u.y = pk2(v[i].z * rstd * gg.z * (1.f + s4.z) + h4.z, v[i].w * rstd * gg.w * (1.f + s4.w) + h4.w);
      *(uint2*)(H + (size_t)m * LDH + k) = u;
    }
  }
}

DI void cache_convert(const Params& p, int g, int l, char* smem) {
  int nt = gridDim.x * 256; asm volatile("" : "+s"(nt));
  const int gt = blockIdx.x * 256 + opaque_tid();
  bf16_t* DK = (bf16_t*)(p.ws + OFF_DK);
  bf16_t* DVT = (bf16_t*)(p.ws + OFF_DVT);
  bf16_t* CKVA = (bf16_t*)(p.ws + OFF_CKVA);
  bf16_t* CKR = (bf16_t*)(p.ws + OFF_CKR);
  for (int i = gt; i < 4 * 512 * 128; i += nt) {
    const int c4 = (i & 127) * 4, pp = (i >> 7) & 511, bl = i >> 16;
    const float4 v = *(const float4*)(p.in[I_CDK] + ((size_t)((g * 4 + bl) * 2 + l) * 512 + pp) * 512 + c4);
    uint2 u; u.x = pk2(v.x, v.y); u.y = pk2(v.z, v.w);
    *(uint2*)(DK + (size_t)(bl * 4608 + 4096 + pp) * 512 + c4) = u;
  }
  {
    float* st = (float*)smem;
    const int tid = opaque_tid();
    for (int item = blockIdx.x; item < 4 * 8 * 8; item += gridDim.x) {
      const int bl = item >> 6, pt = (item >> 3) & 7, ct = item & 7;
      const float* src = p.in[I_CDV] + ((size_t)((g * 4 + bl) * 2 + l) * 512 + pt * 64) * 512 + ct * 64;
      for (int i = tid; i < 4096; i += 256) { const int r = i >> 6, c = i & 63; st[r * 65 + c] = src[(size_t)r * 512 + c]; }
      __syncthreads();
      for (int i = tid; i < 512; i += 256) {
        const int c = i >> 3, pc = (i & 7) * 8;
        uint4 v;
        v.x = pk2(st[(pc + 0) * 65 + c], st[(pc + 1) * 65 + c]); v.y = pk2(st[(pc + 2) * 65 + c], st[(pc + 3) * 65 + c]);
        v.z = pk2(st[(pc + 4) * 65 + c], st[(pc + 5) * 65 + c]); v.w = pk2(st[(pc + 6) * 65 + c], st[(pc + 7) * 65 + c]);
        *(uint4*)(DVT + (size_t)bl * 512 * 4608 + (size_t)(ct * 64 + c) * 4608 + 4096 + pt * 64 + pc) = v;
      }
      __syncthreads();
    }
  }
  for (int i = gt; i < 4 * 512 * 64; i += nt) {
    const int c4 = (i & 63) * 4, pp = (i >> 6) & 511, bl = i >> 15;
    const float4 v = *(const float4*)(p.in[I_CCKV] + ((size_t)((g * 4 + bl) * 2 + l) * 512 + pp) * 256 + c4);
    uint2 u; u.x = pk2(v.x, v.y); u.y = pk2(v.z, v.w);
    *(uint2*)(CKVA + (size_t)(bl * 512 + pp) * 256 + c4) = u;
  }
  for (int i = gt; i < 4 * 512 * 16; i += nt) {
    const int c4 = (i & 15) * 4, pp = (i >> 4) & 511, bl = i >> 13;
    const float4 v = *(const float4*)(p.in[I_CKR] + ((size_t)((g * 4 + bl) * 2 + l) * 512 + pp) * 64 + c4);
    uint2 u; u.x = pk2(v.x, v.y); u.y = pk2(v.z, v.w);
    *(uint2*)(CKR + (size_t)(bl * 512 + pp) * 64 + c4) = u;
  }
}

DI void gemm1_phase(const Params& p, int g, int l, char* smem) {
  const int Tg = g == 0 ? TG : TLG;
  const int MT = Tg / 128;
  constexpr int NT = 30;
  const bf16_t* H = (const bf16_t*)(p.ws + OFF_H);
  const bf16_t* WinT = (const bf16_t*)(p.ws + OFF_W) + (size_t)l * W_LAYER + WO_IN;
  const float* tab = (const float*)(p.ws + OFF_ROPE);
  float* SSQ = (float*)(p.ws + OFF_SSQ);
  for (int it = 0;; ++it) {
    int mt, nt;
    if (!tile_map<NT>(it, MT, mt, nt)) break;
    const int tid = opaque_tid(), lane = tid & 63, wave = tid >> 6, wt = wave >> 1, wf = wave & 1, lr = lane & 31, lh = lane >> 5;
    const int m0 = mt * 128, n0 = nt * 128;
    f32x16 acc[2][2];
    zero_acc<2, 2>(acc);
    gemm_mainloop<2, 2, 2, 2, 64, 1>(H + (size_t)m0 * LDH, LDH, WinT + (size_t)n0 * LW1, LW1, 1024, acc, smem);
    const int F = n0 + wf * 64;
    if (F >= NZ) continue;
#pragma unroll
    for (int tt = 0; tt < 2; ++tt) {
      const int m = m0 + wt * 64 + tt * 32 + lr;
      const Tok t = tokinfo(g, m);
      float v[2][16];
#pragma unroll
      for (int ft = 0; ft < 2; ++ft)
#pragma unroll
        for (int i = 0; i < 16; ++i) v[ft][i] = acc[tt][ft][i];
      if (F < 1024) {
        float ss = 0.f;
#pragma unroll
        for (int ft = 0; ft < 2; ++ft)
#pragma unroll
          for (int i = 0; i < 16; ++i) ss += v[ft][i] * v[ft][i];
        ss = wave_half_sum(ss);
        const float rstd = rsqrtf(ss * (1.f / 64.f) + EPS);
        const float* gn = p.in[F < 512 ? I_DQN : I_DKN] + l * 64;
#pragma unroll
        for (int ft = 0; ft < 2; ++ft)
#pragma unroll
          for (int i = 0; i < 16; ++i) v[ft][i] *= rstd * gn[ft * 32 + (i & 3) + 8 * (i >> 2) + 4 * lh];
        if (t.ctx) {
          if (F >= 512) {
            float* o = p.out + O_NDK + ((size_t)(t.b * 2 + l) * 256 + t.n) * 512 + (F - 512);
            store_sub_f32(o, v[0], lh); store_sub_f32(o + 32, v[1], lh);
          }
        } else {
          rope_sub(v[0], t.n >> 6, lh, tab); rope_sub(v[1], t.n & 63, lh, tab);
        }
        bf16_t* d = (F < 512) ? ((bf16_t*)(p.ws + OFF_DQ) + (size_t)m * LDO + F) : ((bf16_t*)(p.ws + OFF_DK) + (size_t)t.kvrow * 512 + (F - 512));
        store_sub_bf16(d, v[0], lh); store_sub_bf16(d + 32, v[1], lh);
      } else if (F < 1536) {
        const int c = F - 1024;
        if (t.ctx) {
          float* o = p.out + O_NDV + ((size_t)(t.b * 2 + l) * 256 + t.n) * 512 + c;
          store_sub_f32(o, v[0], lh); store_sub_f32(o + 32, v[1], lh);
        }
        const int L = vt_L(t);
        bf16_t* d = (bf16_t*)(p.ws + OFF_DVT) + vt_base(t) + (size_t)c * L + t.n;
        store_sub_T(d, L, v[0], lh); store_sub_T(d + (size_t)32 * L, L, v[1], lh);
      } else if (F < 2048) {
        const bool isk = F >= 1792;
        if (isk) {
#pragma unroll
          for (int ft = 0; ft < 2; ++ft)
#pragma unroll
            for (int i = 0; i < 16; ++i) v[ft][i] *= 0.125f;
        }
        if (!t.ctx) { rope_sub(v[0], t.n >> 6, lh, tab); rope_sub(v[1], t.n & 63, lh, tab); }
        if (!isk) {
          bf16_t* d = (bf16_t*)(p.ws + OFF_RQ) + (size_t)m * 256 + (F - 1536);
          store_sub_bf16(d, v[0], lh); store_sub_bf16(d + 32, v[1], lh);
        } else {
          bf16_t* d = (bf16_t*)(p.ws + OFF_RK) + (size_t)m * 256 + (F - 1792);
          store_sub_bf16(d, v[0], lh); store_sub_bf16(d + 32, v[1], lh);
          const int L = r_L(t);
          bf16_t* dT = (bf16_t*)(p.ws + OFF_RKT) + rkt_base(t) + (size_t)(F - 1792) * L + t.n;
          store_sub_T(dT, L, v[0], lh); store_sub_T(dT + (size_t)32 * L, L, v[1], lh);
        }
      } else if (F < 2560) {
        const int L = r_L(t);
        bf16_t* dT = (bf16_t*)(p.ws + OFF_RVT) + rvt_base(t) + (size_t)(F - 2048) * L + t.n;
        store_sub_T(dT, L, v[0], lh); store_sub_T(dT + (size_t)32 * L, L, v[1], lh);
      } else if (F < 3072) {
        bf16_t* d = (bf16_t*)(p.ws + OFF_RG) + (size_t)m * 512 + (F - 2560);
        store_sub_bf16(d, v[0], lh); store_sub_bf16(d + 32, v[1], lh);
      } else if (F < 3712) {
        const bool isq = F < 3456;
        float ss = 0.f;
#pragma unroll
        for (int ft = 0; ft < 2; ++ft)
#pragma unroll
          for (int i = 0; i < 16; ++i) ss += v[ft][i] * v[ft][i];
        ss = wave_half_sum(ss);
        const int c = isq ? (F - 3072) : (F - 3456);
        if (lh == 0) SSQ[(size_t)m * 16 + (isq ? 0 : 6) + (c >> 6)] = ss;
        const float* gn = p.in[isq ? I_QAN : I_KVAN] + l * (isq ? 384 : 256) + c;
#pragma unroll
        for (int ft = 0; ft < 2; ++ft)
#pragma unroll
          for (int i = 0; i < 16; ++i) v[ft][i] *= gn[ft * 32 + (i & 3) + 8 * (i >> 2) + 4 * lh];
        bf16_t* d = isq ? ((bf16_t*)(p.ws + OFF_MQA) + (size_t)m * 384 + c) : ((bf16_t*)(p.ws + OFF_MKVA) + (size_t)m * 256 + c);
        store_sub_bf16(d, v[0], lh); store_sub_bf16(d + 32, v[1], lh);
      } else {
        if (t.ctx) {
          float* o = p.out + O_NKR + ((size_t)(t.b * 2 + l) * 256 + t.n) * 64;
          store_sub_f32(o, v[0], lh); store_sub_f32(o + 32, v[1], lh);
        }
        bf16_t* d = (bf16_t*)(p.ws + OFF_MKR) + (size_t)m * 64;
        store_sub_bf16(d, v[0], lh); store_sub_bf16(d + 32, v[1], lh);
      }
    }
  }
}

DI void mq_tile(const Params& p, int g, int l, int mt, int head, char* smem) {
  const int tid = opaque_tid(), lane = tid & 63, wave = tid >> 6, lr = lane & 31, lh = lane >> 5;
  const bf16_t* A = (const bf16_t*)(p.ws + OFF_MQA) + (size_t)mt * 128 * 384;
  const bf16_t* B = (const bf16_t*)(p.ws + OFF_W) + (size_t)l * W_LAYER + WO_QB + (size_t)head * 192 * LWQB;
  f32x16 acc[1][6];
  zero_acc<1, 6>(acc);
  gemm_mainloop<4, 1, 1, 6, 32, 1>(A, 384, B, LWQB, 384, acc, smem);
  const int m = mt * 128 + wave * 32 + lr;
  const Tok t = tokinfo(g, m);
  const float* SSQ = (const float*)(p.ws + OFF_SSQ) + (size_t)m * 16;
  const float rq = rsqrtf((SSQ[0] + SSQ[1] + SSQ[2] + SSQ[3] + SSQ[4] + SSQ[5]) * (1.f / 384.f) + EPS);
  float ss = 0.f;
#pragma unroll
  for (int ft = 0; ft < 6; ++ft)
#pragma unroll
    for (int i = 0; i < 16; ++i) { const float x = acc[0][ft][i] * rq; ss += x * x; }
  ss = wave_half_sum(ss);
  const float rh = rsqrtf(ss * (1.f / 192.f) + EPS) * rq;
  const float* gn = p.in[I_MQN] + l * 192;
  const float* tab = (const float*)(p.ws + OFF_ROPE);
  bf16_t* d = (bf16_t*)(p.ws + OFF_MQ) + (size_t)m * 768 + head * 192;
#pragma unroll
  for (int ft = 0; ft < 6; ++ft) {
    float v[16];
#pragma unroll
    for (int i = 0; i < 16; ++i) v[i] = acc[0][ft][i] * rh * gn[ft * 32 + (i & 3) + 8 * (i >> 2) + 4 * lh];
    if (ft >= 4 && !t.ctx) rope_sub(v, ft == 4 ? (t.n >> 6) : (t.n & 63), lh, tab);
    store_sub_bf16(d + ft * 32, v, lh);
  }
}

DI void mkv_tile(const Params& p, int g, int l, int mt, int j, bool cached, char* smem) {
  const int tid = opaque_tid(), lane = tid & 63, wave = tid >> 6, lr = lane & 31, lh = lane >> 5;
  const bf16_t* A = (const bf16_t*)(p.ws + (cached ? OFF_CKVA : OFF_MKVA)) + (size_t)mt * 128 * 256;
  const bf16_t* B = (const bf16_t*)(p.ws + OFF_W) + (size_t)l * W_LAYER + WO_KVB + (size_t)j * 128 * LWKVB;
  f32x16 acc[1][4];
  zero_acc<1, 4>(acc);
  gemm_mainloop<4, 1, 1, 4, 32, 1>(A, 256, B, LWKVB, 256, acc, smem);
  const int m = mt * 128 + wave * 32 + lr;
  const int head = j >> 1;
  int ctx = 0, kvrow, L, pos, n = 0, bb = 0;
  size_t vbase;
  float rkva = 1.f;
  if (cached) {
    const int bl = m >> 9, pp = m & 511;
    kvrow = bl * 4608 + 4096 + pp; L = 4608; pos = 4096 + pp; vbase = (size_t)bl * 512 * 4608;
  } else {
    const Tok t = tokinfo(g, m);
    ctx = t.ctx; kvrow = t.kvrow; L = vt_L(t); pos = t.n; n = t.n; bb = t.b; vbase = vt_base(t);
    const float* SSQ = (const float*)(p.ws + OFF_SSQ) + (size_t)m * 16;
    rkva = rsqrtf((SSQ[6] + SSQ[7] + SSQ[8] + SSQ[9]) * (1.f / 256.f) + EPS);
  }
  if ((j & 1) == 0) {
    const bf16_t* krp = (const bf16_t*)(p.ws + (cached ? OFF_CKR : OFF_MKR)) + (size_t)m * 64 + lh * 32;
    u32x4 krq[4];
#pragma unroll
    for (int q = 0; q < 4; ++q) krq[q] = *(const u32x4*)(krp + q * 8);
    float ss = 0.f;
#pragma unroll
    for (int ft = 0; ft < 4; ++ft)
#pragma unroll
      for (int i = 0; i < 16; ++i) { const float x = acc[0][ft][i] * rkva; ss += x * x; }
#pragma unroll
    for (int q = 0; q < 4; ++q)
#pragma unroll
      for (int e = 0; e < 4; ++e) { const float a = bflo(krq[q][e]), b = bfhi(krq[q][e]); ss += a * a + b * b; }
    ss = wave_half_sum(ss);
    const float rh = rsqrtf(ss * (1.f / 192.f) + EPS);
    const float* gn = p.in[I_MKN] + l * 192;
    bf16_t* d = (bf16_t*)(p.ws + OFF_MK) + (size_t)kvrow * 768 + head * 192;
#pragma unroll
    for (int ft = 0; ft < 4; ++ft) {
      float v[16];
#pragma unroll
      for (int i = 0; i < 16; ++i) v[i] = acc[0][ft][i] * rkva * rh * gn[ft * 32 + (i & 3) + 8 * (i >> 2) + 4 * lh];
      store_sub_bf16(d + ft * 32, v, lh);
    }
    {
      float kr[32];
#pragma unroll
      for (int q = 0; q < 4; ++q)
#pragma unroll
        for (int e = 0; e < 4; ++e) { kr[q * 8 + 2 * e] = bflo(krq[q][e]); kr[q * 8 + 2 * e + 1] = bfhi(krq[q][e]); }
#pragma unroll
      for (int q = 0; q < 32; ++q) kr[q] *= rh * gn[128 + lh * 32 + q];
      if (!cached && !ctx) {
        const float* tab = (const float*)(p.ws + OFF_ROPE);
        const int ps = lh == 0 ? (n >> 6) : (n & 63);
#pragma unroll
        for (int q = 0; q < 16; ++q) {
          const float c = tab[ps * 16 + q], sn = tab[1024 + ps * 16 + q];
          const float x1 = kr[q], x2 = kr[q + 16];
          kr[q] = x1 * c - x2 * sn; kr[q + 16] = x2 * c + x1 * sn;
        }
      }
#pragma unroll
      for (int q = 0; q < 4; ++q) {
        uint4 u;
        u.x = pk2(kr[q * 8 + 0], kr[q * 8 + 1]); u.y = pk2(kr[q * 8 + 2], kr[q * 8 + 3]);
        u.z = pk2(kr[q * 8 + 4], kr[q * 8 + 5]); u.w = pk2(kr[q * 8 + 6], kr[q * 8 + 7]);
        *(uint4*)(d + 128 + lh * 32 + q * 8) = u;
      }
    }
    if (ctx && j == 0) {
      const bf16_t* src = (const bf16_t*)(p.ws + OFF_MKVA) + (size_t)m * 256 + lh * 128;
      float* o = p.out + O_NCKV + ((size_t)(bb * 2 + l) * 256 + n) * 256 + lh * 128;
#pragma unroll 4
      for (int q = 0; q < 16; ++q) {
        const uint4 u = *(const uint4*)(src + q * 8);
        *(float4*)(o + q * 8) = make_float4(bflo(u.x) * rkva, bfhi(u.x) * rkva, bflo(u.y) * rkva, bfhi(u.y) * rkva);
        *(float4*)(o + q * 8 + 4) = make_float4(bflo(u.z) * rkva, bfhi(u.z) * rkva, bflo(u.w) * rkva, bfhi(u.w) * rkva);
      }
    }
  } else {
    bf16_t* dT = (bf16_t*)(p.ws + OFF_MVT) + vbase + (size_t)(head * 128) * L + pos;
#pragma unroll
    for (int ft = 0; ft < 4; ++ft) {
      float v[16];
#pragma unroll
      for (int i = 0; i < 16; ++i) v[i] = acc[0][ft][i] * rkva;
      store_sub_T(dT + (size_t)(ft * 32) * L, L, v, lh);
    }
  }
}

DI void retU_item(const Params& p, int l, int idx, char* smem) {
  const int tid = opaque_tid(), lane = tid & 63, wave = tid >> 6, lr = lane & 31, lh = lane >> 5;
  int head, c, L; size_t kb, vb;
  if (idx < 512) { const int bl = idx >> 7; head = (idx >> 5) & 3; c = idx & 31; L = 4096; kb = (size_t)bl * 256 * 4096; vb = (size_t)bl * 512 * 4096; }
  else { const int r = idx - 512; const int bc = r >> 3; head = (r >> 1) & 3; c = r & 1; L = 256; kb = 4ull * 256 * 4096 + (size_t)bc * 256 * 256; vb = 4ull * 512 * 4096 + (size_t)bc * 512 * 256; }
  const bf16_t* Kt = (const bf16_t*)(p.ws + OFF_RKT) + kb + (size_t)(head * 64) * L + c * 128;
  const bf16_t* Vt = (const bf16_t*)(p.ws + OFF_RVT) + vb + (size_t)(head * 128) * L + c * 128;
  const float xf = p.in[I_RDEC][l * 8 + head], xb = p.in[I_RDEC][l * 8 + 4 + head];
  const float lgf = -log1pf(expf(-xf)) * LOG2E, lgb = -log1pf(expf(-xb)) * LOG2E;
  bf16_t* sKf = (bf16_t*)smem;
  bf16_t* sKb = sKf + 64 * 136;
  bf16x8 vf[8];
#pragma unroll
  for (int ks = 0; ks < 8; ++ks) vf[ks] = *(const bf16x8*)(Vt + (size_t)(wave * 32 + lr) * L + ks * 16 + lh * 8);
  for (int i = tid; i < 1024; i += 256) {
    const int d = i >> 4, tc = (i & 15) * 8;
    const uint4 u = *(const uint4*)(Kt + (size_t)d * L + tc);
    const float x[8] = {bflo(u.x), bfhi(u.x), bflo(u.y), bfhi(u.y), bflo(u.z), bfhi(u.z), bflo(u.w), bfhi(u.w)};
    float wf_[8], wb_[8];
#pragma unroll
    for (int e = 0; e < 8; ++e) { wf_[e] = exp2f(lgf * (float)(127 - tc - e)); wb_[e] = exp2f(lgb * (float)(tc + e)); }
    uint4 a, b;
    a.x = pk2(x[0] * wf_[0], x[1] * wf_[1]); a.y = pk2(x[2] * wf_[2], x[3] * wf_[3]); a.z = pk2(x[4] * wf_[4], x[5] * wf_[5]); a.w = pk2(x[6] * wf_[6], x[7] * wf_[7]);
    b.x = pk2(x[0] * wb_[0], x[1] * wb_[1]); b.y = pk2(x[2] * wb_[2], x[3] * wb_[3]); b.z = pk2(x[4] * wb_[4], x[5] * wb_[5]); b.w = pk2(x[6] * wb_[6], x[7] * wb_[7]);
    *(uint4*)(sKf + d * 136 + tc) = a;
    *(uint4*)(sKb + d * 136 + tc) = b;
  }
  __syncthreads();
  f32x16 af[2], ab[2];
#pragma unroll
  for (int s = 0; s < 2; ++s)
#pragma unroll
    for (int i = 0; i < 16; ++i) { af[s][i] = 0.f; ab[s][i] = 0.f; }
#pragma unroll
  for (int ks = 0; ks < 8; ++ks) {
#pragma unroll
    for (int ds = 0; ds < 2; ++ds) {
      const bf16x8 bF = *(const bf16x8*)(sKf + (ds * 32 + lr) * 136 + ks * 16 + lh * 8);
      const bf16x8 bB = *(const bf16x8*)(sKb + (ds * 32 + lr) * 136 + ks * 16 + lh * 8);
      af[ds] = MFMA(vf[ks], bF, af[ds]);
      ab[ds] = MFMA(vf[ks], bB, ab[ds]);
    }
  }
  float* U = (float*)(p.ws + OFF_U) + (size_t)idx * 2 * 8192;
#pragma unroll
  for (int ds = 0; ds < 2; ++ds)
#pragma unroll
    for (int i = 0; i < 16; ++i) {
      const int e = wave * 32 + (i & 3) + 8 * (i >> 2) + 4 * lh;
      U[e * 64 + ds * 32 + lr] = af[ds][i];
      U[8192 + e * 64 + ds * 32 + lr] = ab[ds][i];
    }
  __syncthreads();
}

DI void p3_phase(const Params& p, int g, int l, char* smem) {
  const int Tg = g == 0 ? TG : TLG;
  const int MT = Tg / 128;
  const int n_mq = MT * 4, n_mkv = MT * 8, n_c = 16 * 8, n_u = g == 0 ? 640 : 512;
  const int G = gridDim.x;
  int o1 = n_mq; while (o1 >= G) o1 -= G;
  int o2 = n_mq + n_mkv; while (o2 >= G) o2 -= G;
  int o3 = n_mq + n_mkv + n_c; while (o3 >= G) o3 -= G;
  int s1 = (int)blockIdx.x - o1; if (s1 < 0) s1 += G;
  int s2 = (int)blockIdx.x - o2; if (s2 < 0) s2 += G;
  int s3 = (int)blockIdx.x - o3; if (s3 < 0) s3 += G;
  for (int t = blockIdx.x; t < n_mq; t += G) mq_tile(p, g, l, t >> 2, t & 3, smem);
  for (int t = s1; t < n_mkv; t += G) mkv_tile(p, g, l, t >> 3, t & 7, false, smem);
  for (int t = s2; t < n_c; t += G) mkv_tile(p, g, l, t >> 3, t & 7, true, smem);
  for (int t = s3; t < n_u; t += G) retU_item(p, l, t, smem);
}

DI void ret_scan_phase(const Params& p, int g, int l) {
  int nthr = gridDim.x * 256; asm volatile("" : "+s"(nthr));
  const int gt = blockIdx.x * 256 + opaque_tid();
  const int nseq_lat = 16, nseq = g == 0 ? 16 + 64 : 16;
  float* Ub = (float*)(p.ws + OFF_U);
  for (int w = gt; w < nseq * 2 * 8192; w += nthr) {
    const int el = w & 8191, dir = (w >> 13) & 1, sq = w >> 14;
    const int e = el >> 6, d = el & 63;
    int head, nc, b, ubase; bool ctx;
    if (sq < nseq_lat) { const int bl = sq >> 2; head = sq & 3; nc = 32; ctx = false; b = g * 4 + bl; ubase = (bl * 4 + head) * 32; }
    else { const int r = sq - nseq_lat; const int bc = r >> 2; head = r & 3; nc = 2; ctx = true; b = bc; ubase = 512 + (bc * 4 + head) * 2; }
    const float x = p.in[I_RDEC][l * 8 + dir * 4 + head];
    const float wgt = exp2f(-log1pf(expf(-x)) * LOG2E * 128.f);
    float R = ctx ? 0.f : p.in[I_SR][((size_t)((b * 2 + l) * 2 + dir) * 4 + head) * 8192 + d * 128 + e];
    float* u = Ub + (size_t)ubase * 2 * 8192 + dir * 8192 + el;
    if (!ctx) {
      float uu[32];
#pragma unroll
      for (int c = 0; c < 32; ++c) uu[c] = u[(size_t)c * 2 * 8192];
      if (dir == 0) {
#pragma unroll
        for (int c = 0; c < 32; ++c) { u[(size_t)c * 2 * 8192] = R; R = wgt * R + uu[c]; }
      } else {
#pragma unroll
        for (int c = 31; c >= 0; --c) { u[(size_t)c * 2 * 8192] = R; R = wgt * R + uu[c]; }
      }
    } else {
      const float t0 = u[0], t1 = u[(size_t)2 * 8192];
      if (dir == 0) { u[0] = R; R = wgt * R + t0; u[(size_t)2 * 8192] = R; R = wgt * R + t1; }
      else { u[(size_t)2 * 8192] = R; R = wgt * R + t1; u[0] = R; R = wgt * R + t0; }
    }
    if (ctx) p.out[O_NSR + ((size_t)((b * 2 + l) * 2 + dir) * 4 + head) * 8192 + d * 128 + e] = R;
  }
}

template <int DQK>
DI void flash_map(const bf16_t* __restrict__ Qrow, const bf16_t* __restrict__ Kb, int ldk, const bf16_t* __restrict__ Vt, int Lkv, int nkeys, float sc,
                  f32x16 (&O)[4], float& lsum, char* smem) {
  constexpr int KS = DQK / 16, KSTR = DQK + 8, NK = DQK / 32;
  const int tid = opaque_tid(), lane = tid & 63, lr = lane & 31, lh = lane >> 5;
  bf16_t* sK = (bf16_t*)smem;
  bf16_t* sV = sK + 64 * KSTR;
  bf16x8 q[KS];
#pragma unroll
  for (int ks = 0; ks < KS; ++ks) q[ks] = *(const bf16x8*)(Qrow + ks * 16 + lh * 8);
#pragma unroll
  for (int et = 0; et < 4; ++et)
#pragma unroll
    for (int i = 0; i < 16; ++i) O[et][i] = 0.f;
  float mrun = -1e30f, lrun = 0.f;
  u32x4 rk[NK], rv[4];
  const bf16_t* kp = Kb + (size_t)(tid >> 2) * ldk + (tid & 3) * 8;
  const bf16_t* vp = Vt + (size_t)(tid >> 1) * Lkv + (tid & 1) * 32;
  bf16_t* skw = sK + (tid >> 2) * KSTR + (tid & 3) * 8;
  bf16_t* svw = sV + (tid >> 1) * 72 + (tid & 1) * 32;
#pragma unroll
  for (int i = 0; i < NK; ++i) rk[i] = *(const u32x4*)(kp + i * 32);
#pragma unroll
  for (int i = 0; i < 4; ++i) rv[i] = *(const u32x4*)(vp + i * 8);
  const int nt = nkeys >> 6;
  const int prow = perm23(lr);
  for (int kt = 0; kt < nt; ++kt) {
#pragma unroll
    for (int i = 0; i < NK; ++i) *(u32x4*)(skw + i * 32) = rk[i];
#pragma unroll
    for (int i = 0; i < 4; ++i) *(u32x4*)(svw + i * 8) = rv[i];
    __syncthreads();
    if (kt + 1 < nt) {
      kp += (size_t)64 * ldk;
      vp += 64;
#pragma unroll
      for (int i = 0; i < NK; ++i) rk[i] = *(const u32x4*)(kp + i * 32);
#pragma unroll
      for (int i = 0; i < 4; ++i) rv[i] = *(const u32x4*)(vp + i * 8);
    }

    f32x16 S[2];
#pragma unroll
    for (int sub = 0; sub < 2; ++sub) {
#pragma unroll
      for (int i = 0; i < 16; ++i) S[sub][i] = 0.f;
#pragma unroll
      for (int ks = 0; ks < KS; ++ks) {
        const bf16x8 a = *(const bf16x8*)(sK + (sub * 32 + prow) * KSTR + ks * 16 + lh * 8);
        S[sub] = MFMA(a, q[ks], S[sub]);
      }

    }
    float mx = S[0][0];
#pragma unroll
    for (int i = 1; i < 16; ++i) mx = fmaxf(mx, S[0][i]);
#pragma unroll
    for (int i = 0; i < 16; ++i) mx = fmaxf(mx, S[1][i]);
    mx = fmaxf(mx, __shfl_xor(mx, 32));
    const float mnew = fmaxf(mrun, mx * sc);
    const bool moved = __builtin_amdgcn_ballot_w64(mnew > mrun) != 0ull;
    float ps = 0.f;
#pragma unroll
    for (int sub = 0; sub < 2; ++sub)
#pragma unroll
      for (int i = 0; i < 16; ++i) { const float e = __builtin_amdgcn_exp2f(S[sub][i] * sc - mnew); S[sub][i] = e; ps += e; }
    if (moved) {
      const float alpha = __builtin_amdgcn_exp2f(mrun - mnew);
      lrun *= alpha;
#pragma unroll
      for (int et = 0; et < 4; ++et)
#pragma unroll
        for (int i = 0; i < 16; ++i) O[et][i] *= alpha;
    }
    mrun = mnew;
    lrun += ps;

#pragma unroll
    for (int sub = 0; sub < 2; ++sub)
#pragma unroll
      for (int s = 0; s < 2; ++s) {
        uint4 u;
        u.x = pk2(S[sub][8 * s + 0], S[sub][8 * s + 1]); u.y = pk2(S[sub][8 * s + 2], S[sub][8 * s + 3]);
        u.z = pk2(S[sub][8 * s + 4], S[sub][8 * s + 5]); u.w = pk2(S[sub][8 * s + 6], S[sub][8 * s + 7]);
        const bf16x8 pf = __builtin_bit_cast(bf16x8, u);
#pragma unroll
        for (int et = 0; et < 4; ++et) {
          const bf16x8 a = *(const bf16x8*)(sV + (et * 32 + lr) * 72 + sub * 32 + s * 16 + lh * 8);
          O[et] = MFMA(a, pf, O[et]);
        }

      }
    __syncthreads();
  }
  lsum = wave_half_sum(lrun);
}

DI void attn_mla_item(const Params& p, int l, bool ctx, int bs, int head, int qt, char* smem) {
  const int tid = opaque_tid(), lane = tid & 63, wave = tid >> 6, lr = lane & 31, lh = lane >> 5;
  const int m = (ctx ? TLG + bs * 256 : bs * 4096) + qt * 128 + wave * 32 + lr;
  const int kv0 = ctx ? 18432 + bs * 256 : bs * 4608;
  const int Lkv = ctx ? 256 : 4608;
  const size_t vb = ctx ? (4ull * 512 * 4608 + (size_t)bs * 512 * 256) : ((size_t)bs * 512 * 4608);
  const bf16_t* Q = (const bf16_t*)(p.ws + OFF_MQ) + (size_t)m * 768 + head * 192;
  const bf16_t* K = (const bf16_t*)(p.ws + OFF_MK) + (size_t)kv0 * 768 + head * 192;
  const bf16_t* Vt = (const bf16_t*)(p.ws + OFF_MVT) + vb + (size_t)(head * 128) * Lkv;
  f32x16 O[4];
  float ls;
  flash_map<192>(Q, K, 768, Vt, Lkv, Lkv, 0.07216878364870322f * LOG2E, O, ls, smem);
  const float il = 1.f / ls;
  bf16_t* d = (bf16_t*)(p.ws + OFF_OM) + (size_t)m * LDO + head * 128;
#pragma unroll
  for (int et = 0; et < 4; ++et) {
    float v[16];
#pragma unroll
    for (int i = 0; i < 16; ++i) v[i] = O[et][i] * il;
    store_sub_bf16(d + et * 32, v, lh);
  }
}

DI void attn_diff_item(const Params& p, int l, bool ctx, int bs, int head, int qt, char* smem) {
  const int tid = opaque_tid(), lane = tid & 63, wave = tid >> 6, lr = lane & 31, lh = lane >> 5;
  const int m = (ctx ? TLG + bs * 256 : bs * 4096) + qt * 128 + wave * 32 + lr;
  const int kv0 = ctx ? 18432 + bs * 256 : bs * 4608;
  const int Lkv = ctx ? 256 : 4608;
  const size_t vb = ctx ? (4ull * 512 * 4608 + (size_t)bs * 512 * 256) : ((size_t)bs * 512 * 4608);
  bf16_t* Qr = (bf16_t*)(p.ws + OFF_DQ) + (size_t)m * LDO + head * 128;
  const bf16_t* K = (const bf16_t*)(p.ws + OFF_DK) + (size_t)kv0 * 512 + head * 128;
  const bf16_t* Vt = (const bf16_t*)(p.ws + OFF_DVT) + vb + (size_t)(head * 128) * Lkv;
  const float lam = ((const float*)(p.ws + OFF_SCAL))[l];
  const float li = 0.8f - 0.6f * expf(-0.3f * (float)l);
  float* o0 = (float*)(p.ws + OFF_O0) + ((size_t)blockIdx.x * 256 + tid) * 64;
  {
    f32x16 O[4];
    float ls;
    flash_map<64>(Qr, K, 512, Vt, Lkv, Lkv, 0.125f * LOG2E, O, ls, smem);
    const float il = 1.f / ls;
#pragma unroll
    for (int et = 0; et < 4; ++et)
#pragma unroll
      for (int q = 0; q < 4; ++q)
        *(float4*)(o0 + et * 16 + q * 4) = make_float4(O[et][q * 4] * il, O[et][q * 4 + 1] * il, O[et][q * 4 + 2] * il, O[et][q * 4 + 3] * il);
    __threadfence_block();
  }
  {
    f32x16 O[4];
    float ls;
    flash_map<64>(Qr + 64, K + 64, 512, Vt, Lkv, Lkv, 0.125f * LOG2E, O, ls, smem);
    const float il = lam / ls;
    float ss = 0.f;
#pragma unroll
    for (int et = 0; et < 4; ++et) {
#pragma unroll
      for (int q = 0; q < 4; ++q) {
        const float4 o = *(const float4*)(o0 + et * 16 + q * 4);
        const float ov[4] = {o.x, o.y, o.z, o.w};
#pragma unroll
        for (int e = 0; e < 4; ++e) { const float x = ov[e] - O[et][q * 4 + e] * il; O[et][q * 4 + e] = x; ss += x * x; }
      }
    }
    ss = wave_half_sum(ss);
    const float rstd = rsqrtf(ss * (1.f / 128.f) + EPS) * (1.f - li);
    const float* gn = p.in[I_DSUB] + l * 128;
#pragma unroll
    for (int et = 0; et < 4; ++et) {
      float v[16];
#pragma unroll
      for (int i = 0; i < 16; ++i) v[i] = O[et][i] * rstd * gn[et * 32 + (i & 3) + 8 * (i >> 2) + 4 * lh];
      store_sub_bf16(Qr + et * 32, v, lh);
    }
  }
}

DI void ret_out_item(const Params& p, int g, int l, int idx, char* smem) {
  const int tid = opaque_tid(), lane = tid & 63, wave = tid >> 6, lr = lane & 31, lh = lane >> 5;
  int head, c, L, nc, m0, b, ubase; bool ctx; size_t vb;
  if (idx < 512) { const int bl = idx >> 7; head = (idx >> 5) & 3; c = idx & 31; L = 4096; nc = 32; ctx = false; m0 = bl * 4096 + c * 128; b = g * 4 + bl; ubase = idx - c; vb = (size_t)bl * 512 * 4096; }
  else { const int r = idx - 512; const int bc = r >> 3; head = (r >> 1) & 3; c = r & 1; L = 256; nc = 2; ctx = true; m0 = TLG + bc * 256 + c * 128; b = bc; ubase = idx - c; vb = 4ull * 512 * 4096 + (size_t)bc * 512 * 256; }
  const float xf = p.in[I_RDEC][l * 8 + head], xb = p.in[I_RDEC][l * 8 + 4 + head];
  const float lgf = -log1pf(expf(-xf)) * LOG2E, lgb = -log1pf(expf(-xb)) * LOG2E;
  const float* U = (const float*)(p.ws + OFF_U) + (size_t)ubase * 2 * 8192;
  bf16_t* sRf = (bf16_t*)smem;
  bf16_t* sRb = sRf + 128 * 72;
  {
    const float* uc = U + (size_t)c * 2 * 8192;
#pragma unroll
    for (int i = 0; i < 8; ++i) {
      const int id = (tid + 256 * i) * 4, e = id >> 6, d = id & 63;
      const float4 a = *(const float4*)(uc + id);
      const float4 bq = *(const float4*)(uc + 8192 + id);
      uint2 ua, ub; ua.x = pk2(a.x, a.y); ua.y = pk2(a.z, a.w); ub.x = pk2(bq.x, bq.y); ub.y = pk2(bq.z, bq.w);
      *(uint2*)(sRf + e * 72 + d) = ua;
      *(uint2*)(sRb + e * 72 + d) = ub;
    }
  }
  __syncthreads();
  const int iq = wave * 32 + lr;
  const int m = m0 + iq;
  const bf16_t* Qp = (const bf16_t*)(p.ws + OFF_RQ) + (size_t)m * 256 + head * 64;
  bf16x8 q[4];
#pragma unroll
  for (int ks = 0; ks < 4; ++ks) q[ks] = *(const bf16x8*)(Qp + ks * 16 + lh * 8);
  f32x16 O[4];
  {
    const float qdf = exp2f(lgf * (float)(iq + 1)), qdb = exp2f(lgb * (float)(128 - iq));
#pragma unroll
    for (int et = 0; et < 4; ++et) {
      f32x16 xf_, xb_;
#pragma unroll
      for (int i = 0; i < 16; ++i) { xf_[i] = 0.f; xb_[i] = 0.f; }
#pragma unroll
      for (int ks = 0; ks < 4; ++ks) {
        const bf16x8 a = *(const bf16x8*)(sRf + (et * 32 + lr) * 72 + ks * 16 + lh * 8);
        const bf16x8 a2 = *(const bf16x8*)(sRb + (et * 32 + lr) * 72 + ks * 16 + lh * 8);
        xf_ = MFMA(a, q[ks], xf_);
        xb_ = MFMA(a2, q[ks], xb_);
      }
#pragma unroll
      for (int i = 0; i < 16; ++i) O[et][i] = qdf * xf_[i] + qdb * xb_[i];
    }
  }
  __syncthreads();
  bf16_t* sK = (bf16_t*)smem;
  bf16_t* sV = sK + 128 * 72;
  {
    const bf16_t* Kp = (const bf16_t*)(p.ws + OFF_RK) + (size_t)m0 * 256 + head * 64;
    const bf16_t* Vt = (const bf16_t*)(p.ws + OFF_RVT) + vb + (size_t)(head * 128) * L + c * 128;
#pragma unroll
    for (int i = 0; i < 4; ++i) { const int ci = tid + 256 * i; *(uint4*)(sK + (ci >> 3) * 72 + (ci & 7) * 8) = *(const uint4*)(Kp + (size_t)(ci >> 3) * 256 + (ci & 7) * 8); }
#pragma unroll
    for (int i = 0; i < 8; ++i) { const int ci = tid + 256 * i; *(uint4*)(sV + (ci >> 4) * 136 + (ci & 15) * 8) = *(const uint4*)(Vt + (size_t)(ci >> 4) * L + (ci & 15) * 8); }
  }
  __syncthreads();
  const int prow = perm23(lr);
#pragma unroll 1
  for (int kt = 0; kt < 4; ++kt) {
    f32x16 S;
#pragma unroll
    for (int i = 0; i < 16; ++i) S[i] = 0.f;
#pragma unroll
    for (int ks = 0; ks < 4; ++ks) {
      const bf16x8 a = *(const bf16x8*)(sK + (kt * 32 + prow) * 72 + ks * 16 + lh * 8);
      S = MFMA(a, q[ks], S);
    }
#pragma unroll
    for (int i = 0; i < 16; ++i) {
      const int j = kt * 32 + 16 * (i >> 3) + 8 * lh + (i & 7);
      const int dl = iq - j;
      S[i] *= (dl >= 0) ? exp2f(lgf * (float)dl) : exp2f(lgb * (float)(-dl));
    }
#pragma unroll
    for (int s = 0; s < 2; ++s) {
      uint4 u;
      u.x = pk2(S[8 * s + 0], S[8 * s + 1]); u.y = pk2(S[8 * s + 2], S[8 * s + 3]);
      u.z = pk2(S[8 * s + 4], S[8 * s + 5]); u.w = pk2(S[8 * s + 6], S[8 * s + 7]);
      const bf16x8 pf = __builtin_bit_cast(bf16x8, u);
#pragma unroll
      for (int et = 0; et < 4; ++et) {
        const bf16x8 a = *(const bf16x8*)(sV + (et * 32 + lr) * 136 + kt * 32 + s * 16 + lh * 8);
        O[et] = MFMA(a, pf, O[et]);
      }
    }
  }
  float ss = 0.f;
#pragma unroll
  for (int et = 0; et < 4; ++et)
#pragma unroll
    for (int i = 0; i < 16; ++i) ss += O[et][i] * O[et][i];
  ss = wave_half_sum(ss);
  const float rstd = rsqrtf(ss * (1.f / 128.f) + EPS);
  const float* gn = p.in[I_RGN] + l * 128;
  const bf16_t* rg = (const bf16_t*)(p.ws + OFF_RG) + (size_t)m * 512 + head * 128;
  bf16_t* d = (bf16_t*)(p.ws + OFF_ORR) + (size_t)m * LDO + head * 128;
#pragma unroll
  for (int et = 0; et < 4; ++et) {
    float v[16];
#pragma unroll
    for (int q4 = 0; q4 < 4; ++q4) {
      const uint2 u = *(const uint2*)(rg + et * 32 + q4 * 8 + lh * 4);
      const float gg[4] = {bflo(u.x), bfhi(u.x), bflo(u.y), bfhi(u.y)};
#pragma unroll
      for (int e = 0; e < 4; ++e) {
        const int i = q4 * 4 + e;
        const float sg = gg[e] / (1.f + expf(-gg[e]));
        v[i] = O[et][i] * rstd * gn[et * 32 + q4 * 8 + lh * 4 + e] * sg;
      }
    }
    store_sub_bf16(d + et * 32, v, lh);
  }
  __syncthreads();
}

DI void p4_phase(const Params& p, int g, int l, char* smem, int* s_item) {
  int* ctr = (int*)(p.ws + OFF_CTR) + (g * 2 + l);
  const int n_lat = 512;
  const int n_ret = g == 0 ? 640 : 512;
  const int n_cx = g == 0 ? 128 : 0;
  const int n_w = (g == 0 && l == 0) ? W_TILES : 0;
  const int total = 2 * n_lat + n_ret + 2 * n_cx + n_w;
  while (true) {
    if (threadIdx.x == 0) *s_item = atomicAdd(ctr, 1);
    __syncthreads();
    int t = *s_item;
    __syncthreads();
    if (t >= total) break;
    if (t < n_lat) attn_mla_item(p, l, false, t >> 7, (t >> 5) & 3, t & 31, smem);
    else if ((t -= n_lat) < n_lat) attn_diff_item(p, l, false, t >> 7, (t >> 5) & 3, t & 31, smem);
    else if ((t -= n_lat) < n_ret) ret_out_item(p, g, l, t, smem);
    else if ((t -= n_ret) < n_cx) attn_mla_item(p, l, true, t >> 3, (t >> 1) & 3, t & 1, smem);
    else if ((t -= n_cx) < n_cx) attn_diff_item(p, l, true, t >> 3, (t >> 1) & 3, t & 1, smem);
    else { t -= n_cx; weight_tile(p, 1, t, smem); }
  }
}

template <int FT>
DI void p5_tile(const Params& p, int l, int mt, int nt, char* smem) {
  const bf16_t* H = (const bf16_t*)(p.ws + OFF_H);
  const bf16_t* Wl = (const bf16_t*)(p.ws + OFF_W) + (size_t)l * W_LAYER;
  bf16_t* MG = (bf16_t*)(p.ws + OFF_MERGED);
  const int tid = opaque_tid(), lane = tid & 63, wave = tid >> 6, wt = wave >> 1, wf = wave & 1, lr = lane & 31, lh = lane >> 5;
  const int m0 = mt * 128, n0 = nt * (64 * FT);
  unsigned mgp[2][FT][8];
#pragma unroll
  for (int a = 0; a < 2; ++a)
#pragma unroll
    for (int b = 0; b < FT; ++b)
#pragma unroll
      for (int i = 0; i < 8; ++i) mgp[a][b][i] = 0u;
#pragma unroll 1
  for (int br = 0; br < 3; ++br) {
    unsigned sg[2][FT][8];
    {
      f32x16 ag[2][FT];
      zero_acc<2, FT>(ag);
      gemm_mainloop<2, 2, 2, FT, 64, 1>(H + (size_t)m0 * LDH, LDH, Wl + WO_IN + (size_t)(NZ + br * 1024 + n0) * LW1, LW1, 1024, ag, smem);
#pragma unroll
      for (int a = 0; a < 2; ++a)
#pragma unroll
        for (int b = 0; b < FT; ++b)
#pragma unroll
          for (int i = 0; i < 8; ++i)
            sg[a][b][i] = pk2(1.f / (1.f + __expf(-ag[a][b][2 * i])), 1.f / (1.f + __expf(-ag[a][b][2 * i + 1])));
    }
    f32x16 ao[2][FT];
    zero_acc<2, FT>(ao);
    const bf16_t* Ob = (const bf16_t*)(p.ws + (br == 0 ? OFF_DQ : (br == 1 ? OFF_ORR : OFF_OM)));
    gemm_mainloop<2, 2, 2, FT, 64, 1>(Ob + (size_t)m0 * LDO, LDO, Wl + WO_BR + (size_t)br * 1024 * LWBR + (size_t)n0 * LWBR, LWBR, 512, ao, smem);
#pragma unroll
    for (int a = 0; a < 2; ++a)
#pragma unroll
      for (int b = 0; b < FT; ++b)
#pragma unroll
        for (int i = 0; i < 8; ++i)
          mgp[a][b][i] = pk2(bflo(mgp[a][b][i]) + bflo(sg[a][b][i]) * ao[a][b][2 * i], bfhi(mgp[a][b][i]) + bfhi(sg[a][b][i]) * ao[a][b][2 * i + 1]);
  }
#pragma unroll
  for (int tt = 0; tt < 2; ++tt) {
    const int m = m0 + wt * 64 + tt * 32 + lr;
#pragma unroll
    for (int ft = 0; ft < FT; ++ft) {
      bf16_t* d = MG + (size_t)m * LDM + n0 + wf * (32 * FT) + ft * 32;
#pragma unroll
      for (int q = 0; q < 4; ++q) { uint2 u; u.x = mgp[tt][ft][q * 2]; u.y = mgp[tt][ft][q * 2 + 1]; *(uint2*)(d + q * 8 + lh * 4) = u; }
    }
  }
}

DI void p5_phase(const Params& p, int g, int l, char* smem) {
  for (int it = 0;; ++it) {
    int mt, nt;
    if (!tile_map<8>(it, 128, mt, nt)) break;
    p5_tile<2>(p, l, mt, nt, smem);
  }
  if (g == 0) {
    for (int it = 0;; ++it) {
      int mt, nt;
      if (!tile_map<16>(it, 32, mt, nt)) break;
      p5_tile<1>(p, l, 128 + mt, nt, smem);
    }
  }
}

template <int FT>
DI void resid_tile(const Params& p, int g, int l, int mode, int mt, int nt, char* smem) {
  const float* xin_p = p.in[I_XP]; const float* xin_s = p.in[I_XS];
  asm volatile("" : "+s"(xin_p), "+s"(xin_s));
  const int tid = opaque_tid(), lane = tid & 63, wave = tid >> 6, wt = wave >> 1, wf = wave & 1, lr = lane & 31, lh = lane >> 5;
  const bf16_t* Wl = (const bf16_t*)(p.ws + OFF_W) + (size_t)l * W_LAYER;
  const bf16_t* A = (const bf16_t*)(p.ws + (mode == 0 ? OFF_MERGED : OFF_UMLP));
  const int K = mode == 0 ? 1024 : 4096;
  const int lda = mode == 0 ? LDM : LDU, ldb = mode == 0 ? LW1 : LWDN;
  const bf16_t* B = Wl + (mode == 0 ? WO_OUT : WO_DN);
  const float* mod = (const float*)(p.ws + OFF_MOD);
  const int m0 = mt * 128, n0 = nt * (64 * FT);
  f32x16 acc[2][FT];
  zero_acc<2, FT>(acc);
  gemm_mainloop<2, 2, 2, FT, (FT == 4 ? 32 : 64), 1>(A + (size_t)m0 * lda, lda, B + (size_t)n0 * ldb, ldb, K, acc, smem);
#pragma unroll
  for (int tt = 0; tt < 2; ++tt) {
    const int m = m0 + wt * 64 + tt * 32 + lr;
    const Tok t = tokinfo(g, m);
    const float* gate = mod + (size_t)(l * 9 + t.cond) * 6144 + (mode == 0 ? 2048 : 5120);
    float* y = p.out + (t.ctx ? O_YP : O_YS) + t.xrow * 1024;
    const float* x = (mode == 0 && l == 0) ? ((t.ctx ? xin_p : xin_s) + t.xrow * 1024) : y;
#pragma unroll
    for (int ft = 0; ft < FT; ++ft)
#pragma unroll
      for (int q = 0; q < 4; ++q) {
        const int f = n0 + wf * (32 * FT) + ft * 32 + q * 8 + lh * 4;
        const float4 xv = *(const float4*)(x + f);
        const float4 gv = *(const float4*)(gate + f);
        float4 o;
        o.x = xv.x + gv.x * acc[tt][ft][q * 4 + 0]; o.y = xv.y + gv.y * acc[tt][ft][q * 4 + 1];
        o.z = xv.z + gv.z * acc[tt][ft][q * 4 + 2]; o.w = xv.w + gv.w * acc[tt][ft][q * 4 + 3];
        *(float4*)(y + f) = o;
      }
  }
}

DI void resid_gemm_phase(const Params& p, int g, int l, int mode, char* smem) {
  for (int it = 0;; ++it) {
    int mt, nt;
    if (!tile_map<4>(it, 128, mt, nt)) break;
    resid_tile<4>(p, g, l, mode, mt, nt, smem);
  }
  if (g == 0) {
    for (int it = 0;; ++it) {
      int mt, nt;
      if (!tile_map<8>(it, 32, mt, nt)) break;
      resid_tile<2>(p, g, l, mode, 128 + mt, nt, smem);
    }
  }
}

DI void up_phase(const Params& p, int g, int l, char* smem) {
  const int Tg = g == 0 ? TG : TLG;
  const int MT = Tg / 128;
  const bf16_t* H = (const bf16_t*)(p.ws + OFF_H);
  const bf16_t* B = (const bf16_t*)(p.ws + OFF_W) + (size_t)l * W_LAYER + WO_UP;
  bf16_t* Uo = (bf16_t*)(p.ws + OFF_UMLP);
  bf16_t* sT = (bf16_t*)smem;
  for (int it = 0;; ++it) {
    int mt, nt;
    if (!tile_map<16>(it, MT, mt, nt)) break;
    const int tid = opaque_tid(), lane = tid & 63, wave = tid >> 6, wt = wave >> 1, wf = wave & 1, lr = lane & 31, lh = lane >> 5;
    const int m0 = mt * 128, n0 = nt * 256;
    f32x16 acc[2][4];
    zero_acc<2, 4>(acc);
    gemm_mainloop<2, 2, 2, 4, 32, 1>(H + (size_t)m0 * LDH, LDH, B + (size_t)n0 * LW1, LW1, 1024, acc, smem);
#pragma unroll
    for (int tt = 0; tt < 2; ++tt) {
      const int r = wt * 64 + tt * 32 + lr;
#pragma unroll
      for (int ft = 0; ft < 4; ++ft) {
        float v[16];
#pragma unroll
        for (int i = 0; i < 16; ++i) { const float x = fmaxf(acc[tt][ft][i], 0.f); v[i] = x * x; }
        store_sub_bf16(sT + r * 264 + wf * 128 + ft * 32, v, lh);
      }
    }
    __syncthreads();
#pragma unroll
    for (int i = 0; i < 16; ++i) {
      const int ci = tid + 256 * i, r = ci >> 5, c = (ci & 31) * 8;
      *(uint4*)(Uo + (size_t)(m0 + r) * LDU + n0 + c) = *(const uint4*)(sT + r * 264 + c);
    }
    __syncthreads();
  }
}

__global__ void __launch_bounds__(256, 2) fwd_megakernel(Params p) {
  cg::grid_group grid = cg::this_grid();
  __shared__ __attribute__((aligned(16))) char smem[73728];
  __shared__ int s_item;
  __shared__ uint4 xb_words;
  if (threadIdx.x == 0) xb_words = make_uint4(0u, 0u, 0u, 0u);
  __syncthreads();
  const XcdBarrier xb = xcd_barrier_post((unsigned*)(p.ws + OFF_BAR), (volatile unsigned*)&xb_words);
  prep_phase(p, smem);
  if (p.ws == nullptr) grid.sync();
  xcd_barrier(xb);
#pragma unroll 1
  for (int g0 = 0; g0 < 2; ++g0) {
#pragma unroll 1
    for (int l0 = 0; l0 < 2; ++l0) {
#define PHASE_GL int g = g0, l = l0; asm volatile("" : "+s"(g), "+s"(l));
      { PHASE_GL rownorm_phase(p, g, l, 0); cache_convert(p, g, l, smem); }
      xcd_barrier(xb);
      { PHASE_GL gemm1_phase(p, g, l, smem); }
      xcd_barrier(xb);
      { PHASE_GL p3_phase(p, g, l, smem); }
      xcd_barrier(xb);
      { PHASE_GL ret_scan_phase(p, g, l); }
      xcd_barrier(xb);
      { PHASE_GL p4_phase(p, g, l, smem, &s_item); }
      xcd_barrier(xb);
      { PHASE_GL p5_phase(p, g, l, smem); }
      xcd_barrier(xb);
#if PROBE_P5
      { PHASE_GL p5_phase(p, g, l, smem); }
      xcd_barrier(xb);
#endif
#if PROBE_G1
      { PHASE_GL gemm1_phase(p, g, l, smem); }
      xcd_barrier(xb);
#endif
#if PROBE_SYNC2
      xcd_barrier(xb); xcd_barrier(xb); xcd_barrier(xb); xcd_barrier(xb); xcd_barrier(xb); xcd_barrier(xb); xcd_barrier(xb); xcd_barrier(xb); xcd_barrier(xb);
#endif
      { PHASE_GL resid_gemm_phase(p, g, l, 0, smem); }
      xcd_barrier(xb);
      { PHASE_GL rownorm_phase(p, g, l, 1); }
      xcd_barrier(xb);
      { PHASE_GL up_phase(p, g, l, smem); }
      xcd_barrier(xb);
#if PROBE_UP2
      { PHASE_GL up_phase(p, g, l, smem); }
      xcd_barrier(xb);
#endif
      { PHASE_GL resid_gemm_phase(p, g, l, 1, smem); }
      xcd_barrier(xb);
    }
  }
}

extern "C" void kernel_launch(void* const* d_in, const int* in_sizes, int n_in, void* d_out,
                              int out_size, void* d_ws, size_t ws_size, hipStream_t stream) {
  static int grid_blocks = 0;
  if (!grid_blocks) {
    int dev = 0, cus = 0, per_cu = 0;
    (void)hipGetDevice(&dev);
    (void)hipDeviceGetAttribute(&cus, hipDeviceAttributeMultiprocessorCount, dev);
    (void)hipOccupancyMaxActiveBlocksPerMultiprocessor(&per_cu, fwd_megakernel, 256, 0);
    if (per_cu > 2) per_cu = 2;
    if (per_cu < 1) per_cu = 1;
    grid_blocks = cus * per_cu;
    if (grid_blocks > 640) grid_blocks = 640;
  }
  Params p{};
  for (int i = 0; i < 30; ++i) p.in[i] = (const float*)d_in[i];
  p.out = (float*)d_out;
  p.ws = (char*)d_ws;
  (void)hipMemsetAsync((char*)d_ws + OFF_CTR, 0, OFF_SSQ - OFF_CTR, stream);
  void* args[] = {&p};
  hipError_t e = hipLaunchCooperativeKernel((void*)fwd_megakernel, dim3(grid_blocks), dim3(256), args, 0, stream);
  if (e != hipSuccess) fprintf(stderr, "cooperative launch failed: %s (grid %d)\n", hipGetErrorString(e), grid_blocks);
}
```
